# Optimizing an MI355X kernel written in HIP

```python
import math
import jax, jax.numpy as jnp
from jax import lax
import numpy as np

D_MODEL = 2048
BATCH = 1
SEQ = 8192
DEPTH = 4

N_A_LAYERS = DEPTH // 2
N_B_LAYERS = DEPTH - N_A_LAYERS
EPS = 1e-6
D_FF = ((8 * D_MODEL // 3 + 255) // 256) * 256
HEAD_DIM_A = 128
N_HEADS_A = D_MODEL // HEAD_DIM_A
DILATED_BRANCHES = ((128, 1), (512, 4), (2048, 16))
N_HEADS_B = D_MODEL // 128
QK_NOPE_DIM = 128
QK_ROPE_DIM = 64
V_HEAD_DIM = 128
KV_LORA_RANK = D_MODEL // 4
Q_LORA_RANK = D_MODEL // 4
ROPE_THETA = 10000.0
Q_BLOCK = 128

kernel_name = "yoco_dilated_swa_mla_macaron"


def rms_norm(x, g):
    xf = x.astype(jnp.float32)
    y = xf * lax.rsqrt(jnp.mean(xf * xf, axis=-1, keepdims=True) + EPS)
    return (y * g.astype(jnp.float32)).astype(x.dtype)


def swiglu(h, w_gate, w_up, w_down):
    return (jax.nn.silu(h @ w_gate) * (h @ w_up)) @ w_down


def alibi_slopes(n_heads):
    return jnp.asarray(2.0 ** (-8.0 * (np.arange(n_heads) + 1) / n_heads), dtype=jnp.float32)


def rope_tables(seq):
    inv = 1.0 / (ROPE_THETA ** (jnp.arange(0, QK_ROPE_DIM, 2, dtype=jnp.float32) / QK_ROPE_DIM))
    ang = jnp.arange(seq, dtype=jnp.float32)[:, None] * inv[None, :]
    return jnp.cos(ang), jnp.sin(ang)


def apply_rope(t, cos, sin):
    tf = t.astype(jnp.float32)
    t1, t2 = jnp.split(tf, 2, axis=-1)
    return jnp.concatenate([t1 * cos - t2 * sin, t1 * sin + t2 * cos], axis=-1).astype(t.dtype)


def dilated_branch(q, k, v, window, dilation, slopes):
    B, S, H, Dh = q.shape
    n = window // dilation
    span = n * dilation
    Sp = -(-S // span) * span
    nb = Sp // span

    def to_blocks(t):
        t = jnp.pad(t, ((0, 0), (0, Sp - S), (0, 0), (0, 0)))
        t = t.reshape(B, Sp // dilation, dilation, H, Dh).transpose(0, 2, 1, 3, 4)
        return t.reshape(B, dilation, nb, n, H, Dh)

    def with_prev(t):
        prev = jnp.pad(t[:, :, :-1], ((0, 0), (0, 0), (1, 0), (0, 0), (0, 0), (0, 0)))
        return jnp.concatenate([prev, t], axis=3)

    qb = to_blocks(q)
    kw = with_prev(to_blocks(k))
    vw = with_prev(to_blocks(v))
    s = jnp.einsum('brcihd,brcjhd->brchij', qb, kw, preferred_element_type=jnp.float32) * (Dh ** -0.5)
    i = jnp.arange(n)[:, None]
    j = jnp.arange(2 * n)[None, :]
    steps = n + i - j
    band = (steps >= 0) & (steps <= n)
    valid = band[None] & ((jnp.arange(nb)[:, None, None] > 0) | (j >= n)[None])
    bias = -slopes[:, None, None] * (dilation * steps).astype(jnp.float32)[None]
    s = jnp.where(valid[None, None, :, None], s + bias[None, None, None], -jnp.inf)
    m = jnp.max(s, axis=-1, keepdims=True)
    p = jnp.exp(s - m)
    l = jnp.sum(p, axis=-1, keepdims=True)
    o = jnp.einsum('brchij,brcjhd->brcihd', (p / l).astype(v.dtype), vw)
    lse = (m + jnp.log(l))[..., 0]
    o = o.reshape(B, dilation, Sp // dilation, H, Dh).transpose(0, 2, 1, 3, 4).reshape(B, Sp, H, Dh)[:, :S]
    lse = lse.transpose(0, 1, 2, 4, 3).reshape(B, dilation, Sp // dilation, H)
    lse = lse.transpose(0, 2, 1, 3).reshape(B, Sp, H)[:, :S]
    return o, lse


def dilated_attention(h, w_qkv, w_o, slopes):
    B, S, _ = h.shape
    qkv = (h @ w_qkv).reshape(B, S, 3, N_HEADS_A, HEAD_DIM_A)
    q, k, v = qkv[:, :, 0], qkv[:, :, 1], qkv[:, :, 2]
    outs, lses = [], []
    for window, dilation in DILATED_BRANCHES:
        o, lse = dilated_branch(q, k, v, window, dilation, slopes)
        outs.append(o)
        lses.append(lse)
    wts = jax.nn.softmax(jnp.stack(lses, axis=0), axis=0)
    o = jnp.einsum('gbsh,gbshd->bshd', wts.astype(q.dtype), jnp.stack(outs, axis=0))
    return o.reshape(B, S, N_HEADS_A * HEAD_DIM_A) @ w_o


def mla_shared_kv(x, kv_norm, b_wdkv, b_ckv_norm, b_wkr, b_wuk, b_wuv, cos, sin):
    h = rms_norm(x, kv_norm)
    c_kv = rms_norm(h @ b_wdkv, b_ckv_norm)
    k_nope = jnp.einsum('bsc,chd->bshd', c_kv, b_wuk)
    v = jnp.einsum('bsc,chd->bshd', c_kv, b_wuv)
    k_rope = apply_rope(h @ b_wkr, cos, sin)
    return k_nope, k_rope, v


def mla_attention(h, k_nope, k_rope, v, w_dq, cq_norm, w_uq, w_o, cos, sin):
    B, S, _ = h.shape
    c_q = rms_norm(h @ w_dq, cq_norm)
    q = jnp.einsum('bsc,chd->bshd', c_q, w_uq)
    q_nope = q[..., :QK_NOPE_DIM]
    q_rope = apply_rope(q[..., QK_NOPE_DIM:], cos[:, None, :], sin[:, None, :])
    nb = S // Q_BLOCK
    qn_b = q_nope.reshape(B, nb, Q_BLOCK, N_HEADS_B, QK_NOPE_DIM).transpose(1, 0, 2, 3, 4)
    qr_b = q_rope.reshape(B, nb, Q_BLOCK, N_HEADS_B, QK_ROPE_DIM).transpose(1, 0, 2, 3, 4)
    starts = jnp.arange(nb, dtype=jnp.int32) * Q_BLOCK
    scale = (QK_NOPE_DIM + QK_ROPE_DIM) ** -0.5
    kpos = jnp.arange(S, dtype=jnp.int32)

    def attend(args):
        qn, qr, start = args
        s = (jnp.einsum('bihd,bjhd->bhij', qn, k_nope, preferred_element_type=jnp.float32)
             + jnp.einsum('bihr,bjr->bhij', qr, k_rope, preferred_element_type=jnp.float32)) * scale
        qpos = start + jnp.arange(Q_BLOCK, dtype=jnp.int32)
        s = jnp.where(kpos[None, :] <= qpos[:, None], s, -jnp.inf)
        p = jax.nn.softmax(s, axis=-1)
        return jnp.einsum('bhij,bjhd->bihd', p.astype(v.dtype), v)

    o = lax.map(attend, (qn_b, qr_b, starts))
    o = o.transpose(1, 0, 2, 3, 4).reshape(B, S, N_HEADS_B * V_HEAD_DIM)
    return o @ w_o


def setup_inputs(seed: int = 0) -> dict:
    key = jax.random.key(seed)
    ks = jax.random.split(key, 24)
    f32 = jnp.float32

    def w(k, shape, fan_in):
        return jax.random.normal(k, shape, f32) * (fan_in ** -0.5)

    def gain(k, shape):
        return 1.0 + 0.01 * jax.random.normal(k, shape, f32)

    D, F = D_MODEL, D_FF
    return {
        "x": jax.random.normal(ks[0], (BATCH, SEQ, D), f32),
        "ffn_norm1": gain(ks[1], (DEPTH, D)),
        "ffn1_wg": w(ks[2], (DEPTH, D, F), D),
        "ffn1_wu": w(ks[3], (DEPTH, D, F), D),
        "ffn1_wd": w(ks[4], (DEPTH, F, D), F),
        "mix_norm": gain(ks[5], (DEPTH, D)),
        "ffn_norm2": gain(ks[6], (DEPTH, D)),
        "ffn2_wg": w(ks[7], (DEPTH, D, F), D),
        "ffn2_wu": w(ks[8], (DEPTH, D, F), D),
        "ffn2_wd": w(ks[9], (DEPTH, F, D), F),
        "a_wqkv": w(ks[10], (N_A_LAYERS, D, 3 * N_HEADS_A * HEAD_DIM_A), D),
        "a_wo": w(ks[11], (N_A_LAYERS, N_HEADS_A * HEAD_DIM_A, D), N_HEADS_A * HEAD_DIM_A),
        "kv_norm": gain(ks[12], (D,)),
        "b_wdkv": w(ks[13], (D, KV_LORA_RANK), D),
        "b_ckv_norm": gain(ks[14], (KV_LORA_RANK,)),
        "b_wkr": w(ks[15], (D, QK_ROPE_DIM), D),
        "b_wuk": w(ks[16], (KV_LORA_RANK, N_HEADS_B, QK_NOPE_DIM), KV_LORA_RANK),
        "b_wuv": w(ks[17], (KV_LORA_RANK, N_HEADS_B, V_HEAD_DIM), KV_LORA_RANK),
        "b_wdq": w(ks[18], (N_B_LAYERS, D, Q_LORA_RANK), D),
        "b_cq_norm": gain(ks[19], (N_B_LAYERS, Q_LORA_RANK)),
        "b_wuq": w(ks[20], (N_B_LAYERS, Q_LORA_RANK, N_HEADS_B, QK_NOPE_DIM + QK_ROPE_DIM), Q_LORA_RANK),
        "b_wo": w(ks[21], (N_B_LAYERS, N_HEADS_B * V_HEAD_DIM, D), N_HEADS_B * V_HEAD_DIM),
        "final_norm": gain(ks[22], (D,)),
    }


def reference(x, ffn_norm1, ffn1_wg, ffn1_wu, ffn1_wd, mix_norm, ffn_norm2, ffn2_wg, ffn2_wu, ffn2_wd,
              a_wqkv, a_wo, kv_norm, b_wdkv, b_ckv_norm, b_wkr, b_wuk, b_wuv,
              b_wdq, b_cq_norm, b_wuq, b_wo, final_norm):
    S = x.shape[1]
    slopes = alibi_slopes(N_HEADS_A)
    cos, sin = rope_tables(S)
    k_nope = k_rope = v_shared = None
    for layer in range(DEPTH):
        if layer == N_A_LAYERS:
            k_nope, k_rope, v_shared = mla_shared_kv(x, kv_norm, b_wdkv, b_ckv_norm, b_wkr, b_wuk, b_wuv, cos, sin)
        x = x + 0.5 * swiglu(rms_norm(x, ffn_norm1[layer]), ffn1_wg[layer], ffn1_wu[layer], ffn1_wd[layer])
        h = rms_norm(x, mix_norm[layer])
        if layer < N_A_LAYERS:
            x = x + dilated_attention(h, a_wqkv[layer], a_wo[layer], slopes)
        else:
            jb = layer - N_A_LAYERS
            x = x + mla_attention(h, k_nope, k_rope, v_shared, b_wdq[jb], b_cq_norm[jb], b_wuq[jb], b_wo[jb], cos, sin)
        x = x + 0.5 * swiglu(rms_norm(x, ffn_norm2[layer]), ffn2_wg[layer], ffn2_wu[layer], ffn2_wd[layer])
    return rms_norm(x, final_norm)
```

```cpp
#include <hip/hip_runtime.h>
#include <cstdio>
#include <cstdint>

#ifndef MK_PER_PHASE
#define MK_PER_PHASE 0
#endif

namespace pg8 {
#define PG8_LAS __attribute__((address_space(3)))
typedef unsigned short bf16_t;
typedef short bf16x8 __attribute__((ext_vector_type(8)));
typedef float f32x4 __attribute__((ext_vector_type(4)));
typedef float f32x2 __attribute__((ext_vector_type(2)));
typedef unsigned u32x4 __attribute__((ext_vector_type(4)));
constexpr int BM = 256, BK = 64, HALF = 128, HTB = HALF * BK * 2  , STAGE_BYTES = 8 * HTB, NXCD = 8, WGM = 8;

__host__ __device__ __forceinline__ int lds_byte(int r, int c) { const int st = (r >> 4) * 2 + (c >> 5), rr = r & 15, cc = c & 31, ob = rr * 64 + cc * 2; return st * 1024 + (ob ^ (((ob >> 9) & 1) << 5)); }
__host__ __device__ __forceinline__ void stage_rc(int b, int& R, int& C) { const int st = b / 1024, sb = b % 1024, swz = sb ^ (((sb >> 9) & 1) << 5); R = (st >> 1) * 16 + swz / 64; C = (st & 1) * 32 + (swz % 64) / 2; }
__host__ __device__ __forceinline__ int perm32(int rho) { const int n = rho >> 4, i = rho & 15; return 8 * (i >> 2) + 4 * n + (i & 3); }

struct Unit { int pm, pn, ks; };
struct Gemm { const bf16_t* A; const bf16_t* Bt; int lda, ldb, K; };

struct StaticOrder {
    int nM, nN, nS, nwg, G, c;
    __host__ __device__ void init(int M, int N, int nS_, int G_, int c_) { nM = M / BM; nN = N / BM; nS = nS_; nwg = nM * nN * nS; G = G_; c = c_; }
    __host__ __device__ bool next(int i, Unit& u) const {
        const long L = (long)i * G + c; if (L >= nwg) return false;
        int wgid = (int)L; { const int q = nwg / NXCD, r = nwg % NXCD, xcd = wgid % NXCD, off = wgid / NXCD; wgid = (xcd < r ? xcd * (q + 1) : r * (q + 1) + (xcd - r) * q) + off; }
        const int nNN = nN * nS, nig = WGM * nNN, gid = wgid / nig, fm = gid * WGM, gsz = (nM - fm) < WGM ? (nM - fm) : WGM;
        u.pm = fm + ((wgid % nig) % gsz); const int pq = (wgid % nig) / gsz; u.pn = pq % nN; u.ks = pq / nN; return true;
    }
    __device__ __forceinline__ void a_ready(const Unit&) const {}
    __device__ __forceinline__ void done(const Unit&) const {}
};

__device__ __forceinline__ unsigned cvt_pk_bf16(float lo, float hi) { unsigned r; asm volatile("v_cvt_pk_bf16_f32 %0, %1, %2" : "=v"(r) : "v"(lo), "v"(hi)); return r; }

__device__ __forceinline__ int opaque_tid() { int t; asm volatile("v_mov_b32 %0, %1" : "=v"(t) : "v"(threadIdx.x)); return t; }
struct EpiBf16 {
    static constexpr bool PERM = true, AFTER_DRAIN = false;
    bf16_t* O; int ldc;
    __device__ __forceinline__ void operator()(const f32x4 (&acc)[2][2][4][2], const Unit& u, int wr, int wc, int fr, int fq) const {
        const int row0 = u.pm * BM + wr * 64 + fr, col0 = u.pn * BM + wc * 32 + 8 * fq;
#pragma unroll
        for (int ai = 0; ai < 2; ++ai)
#pragma unroll
            for (int m = 0; m < 4; ++m) { bf16_t* rowp = O + (size_t)(row0 + ai * HALF + m * 16) * ldc + col0;
#pragma unroll
                for (int bj = 0; bj < 2; ++bj) { const f32x4 v0 = acc[ai][bj][m][0], v1 = acc[ai][bj][m][1];
                    u32x4 w; w.x = cvt_pk_bf16(v0[0], v0[1]); w.y = cvt_pk_bf16(v0[2], v0[3]); w.z = cvt_pk_bf16(v1[0], v1[1]); w.w = cvt_pk_bf16(v1[2], v1[3]);
                    *(u32x4*)(rowp + bj * HALF) = w; } }
    }
};
struct EpiSwiGLU {
    static constexpr bool PERM = true, AFTER_DRAIN = false;
    bf16_t* O; int ldc;
    __device__ __forceinline__ void operator()(const f32x4 (&acc)[2][2][4][2], const Unit& u, int wr, int wc, int fr, int fq) const {
        const int row0 = u.pm * BM + wr * 64 + fr, col0 = u.pn * HALF + wc * 32 + 8 * fq;
#pragma unroll
        for (int ai = 0; ai < 2; ++ai)
#pragma unroll
            for (int m = 0; m < 4; ++m) { bf16_t* rowp = O + (size_t)(row0 + ai * HALF + m * 16) * ldc + col0;
                float r[8];
#pragma unroll
                for (int n = 0; n < 2; ++n)
#pragma unroll
                    for (int e = 0; e < 4; ++e) { const float gv = acc[ai][0][m][n][e], uv = acc[ai][1][m][n][e];
                        const float sg = gv * __builtin_amdgcn_rcpf(1.0f + __builtin_amdgcn_exp2f(-1.4426950408889634f * gv));
                        r[n * 4 + e] = sg * uv; }
                u32x4 w; w.x = cvt_pk_bf16(r[0], r[1]); w.y = cvt_pk_bf16(r[2], r[3]); w.z = cvt_pk_bf16(r[4], r[5]); w.w = cvt_pk_bf16(r[6], r[7]);
                *(u32x4*)rowp = w; }
    }
};
struct EpiResid {
    static constexpr bool PERM = false, AFTER_DRAIN = false;
    const float* base; float* out; int ldc; float scale;
    __device__ __forceinline__ void operator()(const f32x4 (&acc)[2][2][4][2], const Unit& u, int wr, int wc, int fr, int fq) const {
        const int row0 = u.pm * BM + wr * 64 + fr, col0 = u.pn * BM + wc * 32 + 4 * fq;
#pragma unroll
        for (int ai = 0; ai < 2; ++ai)
#pragma unroll
            for (int m = 0; m < 4; ++m) { const size_t off = (size_t)(row0 + ai * HALF + m * 16) * ldc + col0;
                f32x4 b[2][2];
#pragma unroll
                for (int bj = 0; bj < 2; ++bj)
#pragma unroll
                    for (int n = 0; n < 2; ++n) b[bj][n] = *(const f32x4*)(base + off + bj * HALF + n * 16);
#pragma unroll
                for (int bj = 0; bj < 2; ++bj)
#pragma unroll
                    for (int n = 0; n < 2; ++n) *(f32x4*)(out + off + bj * HALF + n * 16) = b[bj][n] + acc[ai][bj][m][n] * scale;
            }
    }
};
struct EpiF32 {
    static constexpr bool PERM = false, AFTER_DRAIN = false;
    float* O; int ldc; size_t slice;
    __device__ __forceinline__ void operator()(const f32x4 (&acc)[2][2][4][2], const Unit& u, int wr, int wc, int fr, int fq) const {
        const int row0 = u.pm * BM + wr * 64 + fr, col0 = u.pn * BM + wc * 32 + 4 * fq; float* Ob = O + (size_t)u.ks * slice;
#pragma unroll
        for (int ai = 0; ai < 2; ++ai)
#pragma unroll
            for (int m = 0; m < 4; ++m) { const size_t off = (size_t)(row0 + ai * HALF + m * 16) * ldc + col0;
#pragma unroll
                for (int bj = 0; bj < 2; ++bj)
#pragma unroll
                    for (int n = 0; n < 2; ++n) *(f32x4*)(Ob + off + bj * HALF + n * 16) = acc[ai][bj][m][n];
            }
    }
};

template <class Epi, class Sched, bool ALIGN_EPI = false, bool SP2 = false>
__device__ __forceinline__ void gemm_phase(PG8_LAS unsigned char* lds, const Gemm g, const Sched& S, const Epi& E) {
    const int tid = opaque_tid(), wid = __builtin_amdgcn_readfirstlane(tid >> 6), lane = tid & 63, wr = wid >> 2, wc = wid & 3, fr = lane & 15, fq = lane >> 4;
    const int K = g.K, nt = K / BK;
#define PG8_UA(u) ((const char*)g.A + ((size_t)(u).pm * BM * g.lda + (size_t)(u).ks * K) * 2)
#define PG8_UB(u) ((const char*)g.Bt + ((size_t)(u).pn * BM * g.ldb + (size_t)(u).ks * K) * 2)
    unsigned voffA[2], voffB[2];
#pragma unroll
    for (int i = 0; i < 2; ++i) { int R, C; stage_rc(tid * 16 + i * 8192, R, C); const int Rb = Epi::PERM ? ((R & ~31) + perm32(R & 31)) : R;
        voffA[i] = (unsigned)(R * g.lda + C) * 2u; voffB[i] = (unsigned)(Rb * g.ldb + C) * 2u; }
    const size_t kstep = (size_t)(BK * 2);
    const size_t hstepA = (size_t)HALF * g.lda * 2, hstepB = (size_t)HALF * g.ldb * 2;
    const unsigned ldsw = (unsigned)wid * 1024u;
    const int aoff = lds_byte(wr * 64 + fr, fq * 8), boff = lds_byte(wc * 32 + fr, fq * 8);
#define PG8_SA(b, h) (((b) * 2 + (h)) * HTB)
#define PG8_SB(b, h) ((4 + (b) * 2 + (h)) * HTB)
#define PG8_STAGE(bufoff, gbase, voff) do { _Pragma("unroll") for (int _i = 0; _i < 2; ++_i) \
        __builtin_amdgcn_global_load_lds((const unsigned*)((const char*)(gbase) + (voff)[_i]), (PG8_LAS unsigned*)(lds + (bufoff) + ldsw + _i * 8192), 16, 0, 0); } while (0)
#define PG8_LDA(dst, b, h) do { _Pragma("unroll") for (int m = 0; m < 4; ++m) _Pragma("unroll") for (int k = 0; k < 2; ++k) dst[m][k] = *(const PG8_LAS bf16x8*)(lds + PG8_SA(b, h) + aoff + m * 2048 + k * 1024); } while (0)
#define PG8_LDB(dst, b, h) do { _Pragma("unroll") for (int n = 0; n < 2; ++n) _Pragma("unroll") for (int k = 0; k < 2; ++k) dst[n][k] = *(const PG8_LAS bf16x8*)(lds + PG8_SB(b, h) + boff + n * 2048 + k * 1024); } while (0)
#define PG8_MMA(ai, bj, At, Bt) do { __builtin_amdgcn_s_setprio(1); _Pragma("unroll") for (int m = 0; m < 4; ++m) _Pragma("unroll") for (int n = 0; n < 2; ++n) _Pragma("unroll") for (int k = 0; k < 2; ++k) \
        acc[ai][bj][m][n] = __builtin_amdgcn_mfma_f32_16x16x32_bf16(Bt[n][k], At[m][k], acc[ai][bj][m][n], 0, 0, 0); __builtin_amdgcn_s_setprio(0); } while (0)
#define PG8_WAIT_V(n) asm volatile("s_waitcnt vmcnt(" #n ")" ::: "memory")
#define PG8_WAIT_L(n) asm volatile("s_waitcnt lgkmcnt(" #n ")" ::: "memory")
#define PG8_BAR __builtin_amdgcn_s_barrier()
#define PG8_SCHED __builtin_amdgcn_sched_barrier(0)
    Unit cur, nxt; int ui = 0;
    if (!S.next(0, cur)) return;
    f32x4 acc[2][2][4][2];
#pragma unroll
    for (int a = 0; a < 2; ++a)
#pragma unroll
        for (int b = 0; b < 2; ++b)
#pragma unroll
            for (int m = 0; m < 4; ++m)
#pragma unroll
                for (int n = 0; n < 2; ++n) acc[a][b][m][n] = (f32x4){0.f, 0.f, 0.f, 0.f};
    bf16x8 At[4][2], B0[2][2], B1[2][2];
    const char* cA = PG8_UA(cur); const char* cB = PG8_UB(cur);
    S.a_ready(cur);
    if constexpr (SP2) {
        PG8_STAGE(PG8_SB(0, 0), cB, voffB); PG8_STAGE(PG8_SB(0, 1), cB + hstepB, voffB); PG8_STAGE(PG8_SA(0, 0), cA, voffA); PG8_STAGE(PG8_SA(0, 1), cA + hstepA, voffA);
        if (wr == 1) PG8_BAR;
        PG8_WAIT_V(2); PG8_BAR;
        PG8_STAGE(PG8_SB(1, 0), cB + kstep, voffB); PG8_STAGE(PG8_SA(1, 0), cA + kstep, voffA); PG8_STAGE(PG8_SB(1, 1), cB + hstepB + kstep, voffB);
        PG8_WAIT_V(6); PG8_BAR;
    } else {
        PG8_STAGE(PG8_SB(0, 0), cB, voffB); PG8_STAGE(PG8_SA(0, 0), cA, voffA); PG8_STAGE(PG8_SB(0, 1), cB + hstepB, voffB); PG8_STAGE(PG8_SA(0, 1), cA + hstepA, voffA);
        if (wr == 1) PG8_BAR;
        PG8_WAIT_V(4); PG8_BAR;
        PG8_STAGE(PG8_SB(1, 0), cB + kstep, voffB); PG8_STAGE(PG8_SA(1, 0), cA + kstep, voffA); PG8_STAGE(PG8_SB(1, 1), cB + hstepB + kstep, voffB);
        PG8_WAIT_V(6); PG8_BAR;
    }
    for (;;) {
        const bool has_next = S.next(ui + 1, nxt);
        const char* nA = has_next ? PG8_UA(nxt) : cA; const char* nB = has_next ? PG8_UB(nxt) : cB;
        for (int t = 0; t < nt; t += 2) {
            const bool last = (t == nt - 2);
            const char* a1 = cA + (size_t)(t + 1) * kstep;
            const char* a2 = last ? nA : cA + (size_t)(t + 2) * kstep; const char* b2 = last ? nB : cB + (size_t)(t + 2) * kstep;
            const char* a3 = a2 + kstep; const char* b3 = b2 + kstep;
            if (last && has_next) S.a_ready(nxt);
            if constexpr (SP2) {
            PG8_LDB(B0, 0, 0); PG8_LDB(B1, 0, 1); PG8_SCHED; PG8_LDA(At, 0, 0); PG8_STAGE(PG8_SA(1, 1), a1 + hstepA, voffA);
            PG8_WAIT_V(8); PG8_WAIT_L(0); PG8_BAR; PG8_MMA(0, 0, At, B0); PG8_MMA(0, 1, At, B1); PG8_BAR; PG8_SCHED;
            PG8_LDA(At, 0, 1); PG8_STAGE(PG8_SB(0, 0), b2, voffB); PG8_STAGE(PG8_SB(0, 1), b2 + hstepB, voffB); PG8_STAGE(PG8_SA(0, 0), a2, voffA);
            PG8_WAIT_V(8); PG8_WAIT_L(0); PG8_BAR; PG8_MMA(1, 0, At, B0); PG8_MMA(1, 1, At, B1); PG8_BAR; PG8_SCHED;
            PG8_LDB(B0, 1, 0); PG8_LDB(B1, 1, 1); PG8_SCHED; PG8_LDA(At, 1, 0); PG8_STAGE(PG8_SA(0, 1), a2 + hstepA, voffA);
            PG8_WAIT_V(8); PG8_WAIT_L(0); PG8_BAR; PG8_MMA(0, 0, At, B0); PG8_MMA(0, 1, At, B1); PG8_BAR; PG8_SCHED;
            PG8_LDA(At, 1, 1); PG8_STAGE(PG8_SB(1, 0), b3, voffB); PG8_STAGE(PG8_SB(1, 1), b3 + hstepB, voffB); PG8_STAGE(PG8_SA(1, 0), a3, voffA);
            PG8_WAIT_V(8); PG8_WAIT_L(0); PG8_BAR; PG8_MMA(1, 0, At, B0); PG8_MMA(1, 1, At, B1); PG8_BAR; PG8_SCHED;
            } else {
            PG8_LDB(B0, 0, 0); PG8_SCHED; PG8_LDA(At, 0, 0); PG8_STAGE(PG8_SA(1, 1), a1 + hstepA, voffA);
            PG8_WAIT_L(8); PG8_BAR; PG8_WAIT_L(0); PG8_MMA(0, 0, At, B0); PG8_BAR; PG8_SCHED;
            PG8_LDB(B1, 0, 1); PG8_STAGE(PG8_SB(0, 0), b2, voffB);
            PG8_BAR; PG8_WAIT_L(0); PG8_MMA(0, 1, At, B1); PG8_BAR;
            PG8_LDA(At, 0, 1); PG8_STAGE(PG8_SA(0, 0), a2, voffA);
            PG8_BAR; PG8_WAIT_L(0); PG8_MMA(1, 0, At, B0); PG8_BAR; PG8_SCHED;
            PG8_STAGE(PG8_SB(0, 1), b2 + hstepB, voffB);
            PG8_WAIT_V(6); PG8_BAR; PG8_MMA(1, 1, At, B1); PG8_BAR;
            PG8_LDB(B0, 1, 0); PG8_SCHED; PG8_LDA(At, 1, 0); PG8_STAGE(PG8_SA(0, 1), a2 + hstepA, voffA);
            PG8_WAIT_L(8); PG8_BAR; PG8_WAIT_L(0); PG8_MMA(0, 0, At, B0); PG8_BAR; PG8_SCHED;
            PG8_LDB(B1, 1, 1); PG8_STAGE(PG8_SB(1, 0), b3, voffB);
            PG8_BAR; PG8_WAIT_L(0); PG8_MMA(0, 1, At, B1); PG8_BAR;
            PG8_LDA(At, 1, 1); PG8_STAGE(PG8_SA(1, 0), a3, voffA);
            PG8_BAR; PG8_WAIT_L(0); PG8_MMA(1, 0, At, B0); PG8_BAR; PG8_SCHED;
            PG8_STAGE(PG8_SB(1, 1), b3 + hstepB, voffB);
            PG8_WAIT_V(6); PG8_BAR; PG8_MMA(1, 1, At, B1); PG8_BAR;
            }
        }
        if constexpr (ALIGN_EPI) { if (wr == 0) PG8_BAR; }
        if constexpr (!Epi::AFTER_DRAIN) { E(acc, cur, wr, wc, fr, fq); S.done(cur); }
        if (!has_next) break;
#pragma unroll
        for (int a = 0; a < 2; ++a)
#pragma unroll
            for (int b = 0; b < 2; ++b)
#pragma unroll
                for (int m = 0; m < 4; ++m)
#pragma unroll
                    for (int n = 0; n < 2; ++n) acc[a][b][m][n] = (f32x4){0.f, 0.f, 0.f, 0.f};
        cur = nxt; cA = nA; cB = nB; ++ui;
        if constexpr (ALIGN_EPI) { if (wr == 1) PG8_BAR; }
    }
    PG8_WAIT_V(0);
    if constexpr (!ALIGN_EPI) { if (wr == 0) PG8_BAR; }
    PG8_BAR;
    if constexpr (Epi::AFTER_DRAIN) { E.fused(acc, cur, wr, wc, fr, fq, lds, wid, lane); S.done(cur); }
#undef PG8_UA
#undef PG8_UB
#undef PG8_SA
#undef PG8_SB
#undef PG8_STAGE
#undef PG8_LDA
#undef PG8_LDB
#undef PG8_MMA
#undef PG8_WAIT_V
#undef PG8_WAIT_L
#undef PG8_BAR
#undef PG8_SCHED
}
}

#define LAS __attribute__((address_space(3)))
#define GAS __attribute__((address_space(1)))
#define XB_TMO      128
#define XB_XCNT(j)  (256  + 64 * (j))
#define XB_XSUB(j)  (1280 + 64 * (j))
#define XB_XGEN(j)  (2304 + 64 * (j))
#define XB_TOP      3328
#define XB_TOPGEN   3392
#define XCD_BAR_WORDS 3456
#define XB_SPIN_CAP (1u << 18)

__device__ __forceinline__ unsigned xb_ld(unsigned* p)              { return __hip_atomic_load(p, __ATOMIC_RELAXED, __HIP_MEMORY_SCOPE_AGENT); }
__device__ __forceinline__ unsigned xb_add(unsigned* p, unsigned v) { return __hip_atomic_fetch_add(p, v, __ATOMIC_RELAXED, __HIP_MEMORY_SCOPE_AGENT); }
__device__ __forceinline__ unsigned xb_xcc_id() { return (unsigned)__builtin_amdgcn_s_getreg((3 << 11) | 20) & 0xFu; }
#define XB_SPIN(cond, bar) do { unsigned _sp = 0; while (cond) { __builtin_amdgcn_s_sleep(1); \
    if ((++_sp & 255u) == 0u) { if (xb_ld(&(bar)[XB_TMO])) break; if (_sp > XB_SPIN_CAP) { atomicAdd(&(bar)[XB_TMO], 1u); break; } } } } while (0)

struct XcdBarrier {
    unsigned* bar; unsigned x;
    volatile LAS unsigned* st;
};

__device__ __forceinline__ XcdBarrier xcd_barrier_post(unsigned* bar, volatile LAS unsigned* st) {
    XcdBarrier b; b.bar = bar; b.x = xb_xcc_id(); b.st = st;
    if (threadIdx.x == 0) (void)xb_add(&bar[XB_XCNT(b.x)], 1u);
    return b;
}
__device__ __forceinline__ void xcd_barrier_complete(unsigned* bar, unsigned x, unsigned& nloc, unsigned& nx) {
    const unsigned G = gridDim.x * gridDim.y * gridDim.z;
    unsigned sum, cnt, mine, sp = 0u;
    for (;;) {
        sum = 0u; cnt = 0u; mine = 0u;
#pragma unroll
        for (unsigned j = 0; j < 16; ++j) { const unsigned c = xb_ld(&bar[XB_XCNT(j)]); sum += c; cnt += (c > 0u) ? 1u : 0u; mine = (j == x) ? c : mine; }
        if (sum == G) break;
        __builtin_amdgcn_s_sleep(1);
        if ((++sp & 255u) == 0u) { if (xb_ld(&bar[XB_TMO])) break; if (sp > XB_SPIN_CAP) { atomicAdd(&bar[XB_TMO], 1u); break; } }
    }
    nloc = mine > 0u ? mine : 1u; nx = cnt > 0u ? cnt : 1u;
}

__device__ __forceinline__ void xcd_barrier(const XcdBarrier& b) {
    asm volatile("s_waitcnt vmcnt(0)" ::: "memory");
    __syncthreads();
    if (threadIdx.x == 0) {
        unsigned* bar = b.bar;
        __builtin_amdgcn_s_waitcnt(0);
        unsigned nloc = b.st[0], nx = b.st[1];
        if (nloc == 0u) { xcd_barrier_complete(bar, b.x, nloc, nx); b.st[0] = nloc; b.st[1] = nx; }
        const unsigned old = xb_add(&bar[XB_XSUB(b.x)], 1u);
        const unsigned gen = old / nloc;
        if (old + 1u == (gen + 1u) * nloc) {
            __builtin_amdgcn_fence(__ATOMIC_RELEASE, "agent");
            asm volatile("s_waitcnt vmcnt(0)" ::: "memory");
            const unsigned og = xb_add(&bar[XB_TOP], 1u);
            const unsigned tg = og / nx;
            if (og + 1u == (tg + 1u) * nx) xb_add(&bar[XB_TOPGEN], 1u);
            else XB_SPIN(xb_ld(&bar[XB_TOPGEN]) == tg, bar);
            __builtin_amdgcn_fence(__ATOMIC_ACQUIRE, "agent");
            xb_add(&bar[XB_XGEN(b.x)], 1u);
            asm volatile("s_waitcnt vmcnt(0)" ::: "memory");
        } else {
            XB_SPIN(xb_ld(&bar[XB_XGEN(b.x)]) == gen, bar);
            __builtin_amdgcn_fence(__ATOMIC_ACQUIRE, "agent");
            asm volatile("s_waitcnt vmcnt(0)" ::: "memory");
        }
    }
    __syncthreads();
}

constexpr int SEQ = 8192, DM = 2048, FF = 5632, NHEAD = 16, HD = 128;
constexpr int NQKV = 3 * DM, NUP = 2 * FF;
constexpr int KVR = 512, NKV1 = 768  , NUKV = 4096, QLR = 512, NQ = NHEAD * 192;
constexpr float EPS = 1e-6f;

constexpr size_t MiB = 1u << 20;
constexpr size_t WS_CTL = 0, CTL_ZERO_BYTES = 1 * MiB;
constexpr size_t WS_ROPE = 1 * MiB;
constexpr size_t WS_W = 4 * MiB;
constexpr size_t WGU_B = (size_t)NUP * DM * 2, WD_B = (size_t)DM * FF * 2, WFFN_B = WGU_B + WD_B;
constexpr size_t WS_WA = WS_W + 8 * WFFN_B, WA_B = 32 * MiB;
constexpr size_t WS_WKV = WS_WA + 2 * WA_B;
constexpr size_t WS_WB = WS_WKV + 8 * MiB, WB_B = 16 * MiB;
constexpr size_t WS_HB = WS_WB + 2 * WB_B;
constexpr size_t WS_ACT = WS_HB + 32 * MiB;
constexpr size_t WS_QKV = WS_ACT + 88 * MiB;
constexpr size_t WS_AO = WS_QKV + 96 * MiB;
constexpr size_t WS_KV = WS_AO + 32 * MiB;
constexpr size_t WS_KR = WS_KV + 64 * MiB;
constexpr size_t WS_CB = WS_KR + 1 * MiB;
constexpr size_t WS_END = WS_CB + 8 * MiB;
static_assert(WGU_B == 44 * MiB && WD_B == 22 * MiB, "weight sizes");
constexpr int CW_TMO = 0, CW_BAR = 4096;

constexpr int RING_OFF = 0, RING_BYTES = 131072;
constexpr int LDSCTL_OFF = RING_BYTES, MISC_OFF = LDSCTL_OFF + 320;
constexpr int LDS_BYTES = 147456;
constexpr int NWAVES = 8;

typedef unsigned short bf16;
typedef unsigned v4u __attribute__((ext_vector_type(4)));
typedef unsigned v2u __attribute__((ext_vector_type(2)));
typedef float f32x4 __attribute__((ext_vector_type(4)));
typedef float f32x2 __attribute__((ext_vector_type(2)));
#define LDS_WAIT() asm volatile("s_waitcnt lgkmcnt(0)" ::: "memory")
#define VM_WAIT() asm volatile("s_waitcnt vmcnt(0)" ::: "memory")
__device__ __forceinline__ unsigned f2bf(float f) { unsigned u = __builtin_bit_cast(unsigned, f); return (u + 0x7fffu + ((u >> 16) & 1u)) >> 16; }
__device__ __forceinline__ unsigned pk2(float lo, float hi) { return f2bf(lo) | (f2bf(hi) << 16); }
__device__ __forceinline__ float bflo(unsigned u) { return __builtin_bit_cast(float, u << 16); }
__device__ __forceinline__ float bfhi(unsigned u) { return __builtin_bit_cast(float, u & 0xffff0000u); }
__device__ __forceinline__ float wave_sum(float v) {
#pragma unroll
    for (int o = 1; o < 64; o <<= 1) v += __shfl_xor(v, o);
    return v;
}

struct Frame { LAS unsigned char* lds; unsigned* ctl; int tid, lane, wave, G, gw, NGW; };

__device__ __forceinline__ void tr_item(const float* W, int ldw, bf16* WT, int K, int drow0, int k0, int n0, LAS float* scr, int lane) {
#pragma unroll 8
    for (int i = 0; i < 32; ++i) { const int kk = 2 * i + (lane >> 5); scr[kk * 33 + (lane & 31)] = W[(size_t)(k0 + kk) * ldw + n0 + (lane & 31)]; }
    LDS_WAIT(); asm volatile("" ::: "memory");
    const int c = lane & 7;
#pragma unroll
    for (int j = 0; j < 4; ++j) { const int n = (lane >> 3) + 8 * j; const LAS float* s = scr + (8 * c) * 33 + n;
        v4u o; o.x = pk2(s[0 * 33], s[1 * 33]); o.y = pk2(s[2 * 33], s[3 * 33]); o.z = pk2(s[4 * 33], s[5 * 33]); o.w = pk2(s[6 * 33], s[7 * 33]);
        *(v4u*)(WT + (size_t)(drow0 + n) * K + k0 + 8 * c) = o; }
    LDS_WAIT(); asm volatile("" ::: "memory");
}
__device__ __forceinline__ void tr_mat(const float* W, int K, int N, bf16* WT, int rowoff, int mode, int r, LAS float* scr, int lane) {
    const int nbk = N / 32, kb = r / nbk, nb = r % nbk, n0 = nb * 32;
    const int drow0 = rowoff + (mode ? ((n0 >> 7) * 256 + (n0 & 127)) : n0);
    tr_item(W, N, WT, K, drow0, kb * 64, n0, scr, lane);
}

struct Args { const float* in[23]; float* out; unsigned char* ws; int ph_lo, ph_hi; };

__device__ __forceinline__ void p0_prologue(const Frame& F, const Args& a) {
    LAS float* scr = (LAS float*)(F.lds + RING_OFF + F.wave * 16384);
    unsigned char* ws = a.ws;
    constexpr int I_FFN1 = (DM / 64) * (FF / 32);
    constexpr int I_FFN = 3 * I_FFN1;
    constexpr int I_QKV = (DM / 64) * (NQKV / 32), I_O = (DM / 64) * (DM / 32), I_A = I_QKV + I_O;
    constexpr int I_DKV = (DM / 64) * (KVR / 32), I_KR = (DM / 64) * (64 / 32), I_UK = (KVR / 64) * (DM / 32), I_KV = I_DKV + I_KR + 2 * I_UK;
    constexpr int I_DQ = (DM / 64) * (QLR / 32), I_UQ = (QLR / 64) * (NQ / 32), I_B = I_DQ + I_UQ + I_O;
    constexpr int NITEMS = 8 * I_FFN + 2 * I_A + I_KV + 2 * I_B;
    for (int it = F.gw; it < NITEMS; it += F.NGW) {
        int r = it;
        if (r < 8 * I_FFN) { const int s = r / I_FFN; r -= s * I_FFN; const int layer = s >> 1, which = s & 1;
            bf16* wgu = (bf16*)(ws + WS_W + (size_t)s * WFFN_B); bf16* wd = (bf16*)(ws + WS_W + (size_t)s * WFFN_B + WGU_B);
            if (r < I_FFN1) { tr_mat(a.in[which ? 7 : 2] + (size_t)layer * DM * FF, DM, FF, wgu, 0, 1, r, scr, F.lane); continue; } r -= I_FFN1;
            if (r < I_FFN1) { tr_mat(a.in[which ? 8 : 3] + (size_t)layer * DM * FF, DM, FF, wgu, 128, 1, r, scr, F.lane); continue; } r -= I_FFN1;
            tr_mat(a.in[which ? 9 : 4] + (size_t)layer * FF * DM, FF, DM, wd, 0, 0, r, scr, F.lane); continue; }
        r -= 8 * I_FFN;
        if (r < 2 * I_A) { const int l = r / I_A; r -= l * I_A;
            bf16* wqkv = (bf16*)(ws + WS_WA + (size_t)l * WA_B); bf16* wo = (bf16*)(ws + WS_WA + (size_t)l * WA_B + 24 * MiB);
            if (r < I_QKV) { tr_mat(a.in[10] + (size_t)l * DM * NQKV, DM, NQKV, wqkv, 0, 0, r, scr, F.lane); continue; } r -= I_QKV;
            tr_mat(a.in[11] + (size_t)l * DM * DM, DM, DM, wo, 0, 0, r, scr, F.lane); continue; }
        r -= 2 * I_A;
        if (r < I_KV) { bf16* wdkv = (bf16*)(ws + WS_WKV); bf16* wukv = (bf16*)(ws + WS_WKV + 3 * MiB);
            if (r < I_DKV) { tr_mat(a.in[13], DM, KVR, wdkv, 0, 0, r, scr, F.lane); continue; } r -= I_DKV;
            if (r < I_KR) { tr_mat(a.in[15], DM, 64, wdkv, KVR, 0, r, scr, F.lane); continue; } r -= I_KR;
            if (r < I_UK) { tr_mat(a.in[16], KVR, DM, wukv, 0, 0, r, scr, F.lane); continue; } r -= I_UK;
            tr_mat(a.in[17], KVR, DM, wukv, DM, 0, r, scr, F.lane); continue; }
        r -= I_KV;
        { const int l = r / I_B; r -= l * I_B;
            bf16* wdq = (bf16*)(ws + WS_WB + (size_t)l * WB_B); bf16* wuq = (bf16*)(ws + WS_WB + (size_t)l * WB_B + 2 * MiB); bf16* wo = (bf16*)(ws + WS_WB + (size_t)l * WB_B + 8 * MiB);
            if (r < I_DQ) { tr_mat(a.in[18] + (size_t)l * DM * QLR, DM, QLR, wdq, 0, 0, r, scr, F.lane); continue; } r -= I_DQ;
            if (r < I_UQ) { tr_mat(a.in[20] + (size_t)l * QLR * NQ, QLR, NQ, wuq, 0, 0, r, scr, F.lane); continue; } r -= I_UQ;
            tr_mat(a.in[21] + (size_t)l * DM * DM, DM, DM, wo, 0, 0, r, scr, F.lane); }
    }
    const int gt = blockIdx.x * (NWAVES * 64) + F.tid, NGT = F.G * NWAVES * 64;
    { v4u* z = (v4u*)(ws + WS_WKV + (size_t)576 * DM * 2); const v4u zero = {0u, 0u, 0u, 0u};
      for (int i = gt; i < (NKV1 - 576) * DM * 2 / 16; i += NGT) z[i] = zero; }
    { f32x2* tab = (f32x2*)(ws + WS_ROPE);
      for (int i = gt; i < SEQ * 32; i += NGT) { const int pos = i >> 5, j = i & 31;
          const float inv = 1.0f / exp2f((float)j * (13.287712379549449f / 32.0f));
          const float ang = (float)pos * inv;
          double t = (double)ang * 0.15915494309189535; t -= floor(t); const float tf = (float)t;
          f32x2 cs; cs.x = __builtin_amdgcn_cosf(tf); cs.y = __builtin_amdgcn_sinf(tf); tab[i] = cs; } }
}

__device__ __forceinline__ void norm_rows_bf16(const Frame& F, const float* x, const float* gain, bf16* out) {
    for (int m = F.gw; m < SEQ; m += F.NGW) {
        const f32x4* xr = (const f32x4*)(x + (size_t)m * DM) + F.lane; const f32x4* g4 = (const f32x4*)gain + F.lane;
        f32x4 v[8]; float s = 0.f;
#pragma unroll
        for (int j = 0; j < 8; ++j) { v[j] = xr[64 * j]; s += (v[j].x * v[j].x + v[j].y * v[j].y) + (v[j].z * v[j].z + v[j].w * v[j].w); }
        const float rstd = 1.0f / sqrtf(wave_sum(s) * (1.0f / DM) + EPS);
        v2u* o = (v2u*)(out + (size_t)m * DM) + F.lane;
#pragma unroll
        for (int j = 0; j < 8; ++j) { const f32x4 g = g4[64 * j]; v2u w; w.x = pk2(v[j].x * rstd * g.x, v[j].y * rstd * g.y); w.y = pk2(v[j].z * rstd * g.z, v[j].w * rstd * g.w); o[64 * j] = w; }
    }
}
__device__ __forceinline__ void norm_rows_f32(const Frame& F, const float* x, const float* gain, float* out) {
    for (int m = F.gw; m < SEQ; m += F.NGW) {
        const f32x4* xr = (const f32x4*)(x + (size_t)m * DM) + F.lane; const f32x4* g4 = (const f32x4*)gain + F.lane;
        f32x4 v[8]; float s = 0.f;
#pragma unroll
        for (int j = 0; j < 8; ++j) { v[j] = xr[64 * j]; s += (v[j].x * v[j].x + v[j].y * v[j].y) + (v[j].z * v[j].z + v[j].w * v[j].w); }
        const float rstd = 1.0f / sqrtf(wave_sum(s) * (1.0f / DM) + EPS);
        f32x4* o = (f32x4*)(out + (size_t)m * DM) + F.lane;
#pragma unroll
        for (int j = 0; j < 8; ++j) { const f32x4 g = g4[64 * j]; o[64 * j] = v[j] * rstd * g; }
    }
}
template <int NS, int LD, bool KR>
__device__ __forceinline__ void latent_post(const Frame& F, const float* raw, const float* gain, bf16* cb, bf16* kr, const f32x2* ropetab) {
    for (int m = F.gw; m < SEQ; m += F.NGW) {
        f32x4 v0 = {0.f, 0.f, 0.f, 0.f}, v1 = {0.f, 0.f, 0.f, 0.f}; float t1 = 0.f, t2 = 0.f;
#pragma unroll
        for (int p = 0; p < NS; ++p) { const float* rr = raw + (size_t)p * SEQ * LD + (size_t)m * LD;
            v0 += *(const f32x4*)(rr + 8 * F.lane); v1 += *(const f32x4*)(rr + 8 * F.lane + 4);
            if (KR) { t1 += rr[512 + (F.lane & 31)]; t2 += rr[544 + (F.lane & 31)]; } }
        const float s = (v0.x * v0.x + v0.y * v0.y) + (v0.z * v0.z + v0.w * v0.w) + (v1.x * v1.x + v1.y * v1.y) + (v1.z * v1.z + v1.w * v1.w);
        const float rstd = 1.0f / sqrtf(wave_sum(s) * (1.0f / 512.0f) + EPS);
        const f32x4 g0 = *(const f32x4*)(gain + 8 * F.lane), g1 = *(const f32x4*)(gain + 8 * F.lane + 4);
        v4u w; w.x = pk2(v0.x * rstd * g0.x, v0.y * rstd * g0.y); w.y = pk2(v0.z * rstd * g0.z, v0.w * rstd * g0.w);
        w.z = pk2(v1.x * rstd * g1.x, v1.y * rstd * g1.y); w.w = pk2(v1.z * rstd * g1.z, v1.w * rstd * g1.w);
        *(v4u*)(cb + (size_t)m * 512 + 8 * F.lane) = w;
        if (KR) { const f32x2 cs = ropetab[m * 32 + (F.lane & 31)];
            const float r = (F.lane < 32) ? (t1 * cs.x - t2 * cs.y) : (t1 * cs.y + t2 * cs.x);
            kr[(size_t)m * 64 + F.lane] = (bf16)f2bf(r); }
    }
}
__device__ __forceinline__ void q_rope(const Frame& F, bf16* q, const f32x2* ropetab) {
    for (int m = F.gw; m < SEQ; m += F.NGW) {
        bf16* qr = q + (size_t)m * NQ;
#pragma unroll
        for (int k = 0; k < 8; ++k) { const int pi = k * 64 + F.lane, h = pi >> 5, j = pi & 31;
            const f32x2 cs = ropetab[m * 32 + j];
            const float t1 = bflo(qr[h * 192 + 128 + j]), t2 = bflo(qr[h * 192 + 160 + j]);
            qr[h * 192 + 128 + j] = (bf16)f2bf(t1 * cs.x - t2 * cs.y); qr[h * 192 + 160 + j] = (bf16)f2bf(t1 * cs.y + t2 * cs.x); }
    }
}

__device__ __forceinline__ void attn_dilated_naive(const Frame& F, const bf16* qkv, bf16* ao) {
    const float L2E = 1.4426950408889634f, SC = 0.08838834764831845f;
    for (int t = F.gw; t < SEQ * NHEAD; t += F.NGW) {
        const int p = t >> 4, h = t & 15;
        const float slope = exp2f(-0.5f * (float)(h + 1));
        const unsigned qv = *(const unsigned*)(qkv + (size_t)p * NQKV + h * HD + 2 * F.lane);
        const float q0 = bflo(qv) * SC, q1 = bfhi(qv) * SC;
        float mx = -1e30f, l = 0.f, o0 = 0.f, o1 = 0.f;
        for (int g = 0; g < 3; ++g) { const int d = 1 << (2 * g);
            for (int s0 = 0; s0 <= 128; s0 += 8) {
                unsigned kk[8], vv[8];
#pragma unroll
                for (int j = 0; j < 8; ++j) { const int s = s0 + j, kp = p - s * d; const bool ok = (s <= 128) && (kp >= 0); const int kc = ok ? kp : p;
                    kk[j] = *(const unsigned*)(qkv + (size_t)kc * NQKV + DM + h * HD + 2 * F.lane);
                    vv[j] = *(const unsigned*)(qkv + (size_t)kc * NQKV + 2 * DM + h * HD + 2 * F.lane); }
#pragma unroll
                for (int j = 0; j < 8; ++j) { const int s = s0 + j, kp = p - s * d; const bool ok = (s <= 128) && (kp >= 0);
                    float dot = wave_sum(q0 * bflo(kk[j]) + q1 * bfhi(kk[j]));
                    const float sc = ok ? (dot - slope * (float)(d * s)) : -__builtin_inff();
                    const float mn = fmaxf(mx, sc), al = exp2f((mx - mn) * L2E), pr = exp2f((sc - mn) * L2E);
                    l = l * al + pr; o0 = o0 * al + pr * bflo(vv[j]); o1 = o1 * al + pr * bfhi(vv[j]); mx = mn; }
            }
        }
        const float il = 1.0f / l;
        *(unsigned*)(ao + (size_t)p * DM + h * HD + 2 * F.lane) = pk2(o0 * il, o1 * il);
    }
}
__device__ __forceinline__ void attn_mla_naive(const Frame& F, const bf16* q, const bf16* kv, const bf16* kr, bf16* ao) {
    const float L2E = 1.4426950408889634f, SC = 0.07216878364870322f;
    for (int t = F.gw; t < SEQ * NHEAD; t += F.NGW) {
        const int i = t >> 4, h = t & 15;
        const unsigned qv = *(const unsigned*)(q + (size_t)i * NQ + h * 192 + 2 * F.lane);
        const unsigned qrv = (F.lane < 32) ? *(const unsigned*)(q + (size_t)i * NQ + h * 192 + 128 + 2 * F.lane) : 0u;
        const float q0 = bflo(qv) * SC, q1 = bfhi(qv) * SC, q2 = bflo(qrv) * SC, q3 = bfhi(qrv) * SC;
        float mx = -1e30f, l = 0.f, o0 = 0.f, o1 = 0.f;
        for (int j0 = 0; j0 <= i; j0 += 8) {
            unsigned kk[8], kq[8], vv[8];
#pragma unroll
            for (int j = 0; j < 8; ++j) { const int jj = j0 + j, jc = jj <= i ? jj : i;
                kk[j] = *(const unsigned*)(kv + (size_t)jc * NUKV + h * HD + 2 * F.lane);
                kq[j] = (F.lane < 32) ? *(const unsigned*)(kr + (size_t)jc * 64 + 2 * F.lane) : 0u;
                vv[j] = *(const unsigned*)(kv + (size_t)jc * NUKV + DM + h * HD + 2 * F.lane); }
#pragma unroll
            for (int j = 0; j < 8; ++j) { const bool ok = (j0 + j) <= i;
                float dot = wave_sum((q0 * bflo(kk[j]) + q1 * bfhi(kk[j])) + (q2 * bflo(kq[j]) + q3 * bfhi(kq[j])));
                const float sc = ok ? dot : -__builtin_inff();
                const float mn = fmaxf(mx, sc), al = exp2f((mx - mn) * L2E), pr = exp2f((sc - mn) * L2E);
                l = l * al + pr; o0 = o0 * al + pr * bflo(vv[j]); o1 = o1 * al + pr * bfhi(vv[j]); mx = mn; }
        }
        const float il = 1.0f / l;
        *(unsigned*)(ao + (size_t)i * DM + h * HD + 2 * F.lane) = pk2(o0 * il, o1 * il);
    }
}

__global__ void __launch_bounds__(NWAVES * 64, 2) mk_fwd(Args args) {
    extern __shared__ __attribute__((aligned(16))) unsigned char lds_raw[];
    LAS unsigned char* const LDSB = (LAS unsigned char*)lds_raw;
    volatile LAS unsigned* MISC = (volatile LAS unsigned*)(LDSB + MISC_OFF);
    unsigned char* ws = args.ws;
    unsigned* const CTL = (unsigned*)(ws + WS_CTL);
    for (int u = threadIdx.x; u < (LDS_BYTES - LDSCTL_OFF) / 4; u += NWAVES * 64) ((LAS unsigned*)(LDSB + LDSCTL_OFF))[u] = 0u;
    __syncthreads();
    XcdBarrier bar; bar.bar = CTL + CW_BAR; bar.x = 0; bar.st = nullptr;
    if (!MK_PER_PHASE) bar = xcd_barrier_post(CTL + CW_BAR, MISC + 8);
    const int lo = args.ph_lo, hi = args.ph_hi;
    int ph = 0;
#define PH_BEGIN if (ph >= lo && ph < hi) { Frame F; F.lds = LDSB; F.ctl = CTL; F.tid = pg8::opaque_tid(); F.lane = F.tid & 63; F.wave = __builtin_amdgcn_readfirstlane(F.tid >> 6); F.G = gridDim.x; F.gw = blockIdx.x * NWAVES + F.wave; F.NGW = F.G * NWAVES;
#define PH_END } ++ph; if (!MK_PER_PHASE && ph > lo && ph < hi) xcd_barrier(bar);

    float* X = args.out;
    bf16* HB = (bf16*)(ws + WS_HB); bf16* ACT = (bf16*)(ws + WS_ACT); bf16* QKV = (bf16*)(ws + WS_QKV); bf16* AO = (bf16*)(ws + WS_AO);
    bf16* KV = (bf16*)(ws + WS_KV); bf16* KR = (bf16*)(ws + WS_KR); bf16* CB = (bf16*)(ws + WS_CB);
    float* RAW = (float*)(ws + WS_ACT);
    const f32x2* ROPETAB = (const f32x2*)(ws + WS_ROPE);
    const int bx = blockIdx.x;

    PH_BEGIN p0_prologue(F, args); PH_END

    for (int s = 0; s < 8; ++s) {
        const int layer = s >> 1, which = s & 1;
        const float* xin = (s == 0) ? args.in[0] : X;
        if (s == 4) {
            PH_BEGIN norm_rows_bf16(F, X, args.in[12], HB); PH_END
            PH_BEGIN { pg8::Gemm g{HB, (const bf16*)(ws + WS_WKV), DM, DM, DM / 2}; pg8::StaticOrder S; S.init(SEQ, NKV1, 2, F.G, bx);
                       pg8::EpiF32 E{RAW, NKV1, (size_t)SEQ * NKV1};
                       pg8::gemm_phase<pg8::EpiF32, pg8::StaticOrder, true, true>(F.lds + RING_OFF, g, S, E); } PH_END
            PH_BEGIN latent_post<2, NKV1, true>(F, RAW, args.in[14], CB, KR, ROPETAB); PH_END
            PH_BEGIN { pg8::Gemm g{CB, (const bf16*)(ws + WS_WKV + 3 * MiB), KVR, KVR, KVR}; pg8::StaticOrder S; S.init(SEQ, NUKV, 1, F.G, bx);
                       pg8::EpiBf16 E{KV, NUKV};
                       pg8::gemm_phase<pg8::EpiBf16, pg8::StaticOrder, true, true>(F.lds + RING_OFF, g, S, E); } PH_END
        }
        PH_BEGIN norm_rows_bf16(F, xin, args.in[which ? 6 : 1] + (size_t)layer * DM, HB); PH_END
        PH_BEGIN { pg8::Gemm g{HB, (const bf16*)(ws + WS_W + (size_t)s * WFFN_B), DM, DM, DM}; pg8::StaticOrder S; S.init(SEQ, NUP, 1, F.G, bx);
                   pg8::EpiSwiGLU E{ACT, FF};
                   pg8::gemm_phase<pg8::EpiSwiGLU, pg8::StaticOrder, true, true>(F.lds + RING_OFF, g, S, E); } PH_END
        PH_BEGIN { pg8::Gemm g{ACT, (const bf16*)(ws + WS_W + (size_t)s * WFFN_B + WGU_B), FF, FF, FF}; pg8::StaticOrder S; S.init(SEQ, DM, 1, F.G, bx);
                   pg8::EpiResid E{xin, X, DM, 0.5f};
                   pg8::gemm_phase<pg8::EpiResid, pg8::StaticOrder, true, true>(F.lds + RING_OFF, g, S, E); } PH_END
        if (which == 0) {
            PH_BEGIN norm_rows_bf16(F, X, args.in[5] + (size_t)layer * DM, HB); PH_END
            if (layer < 2) {
                PH_BEGIN { pg8::Gemm g{HB, (const bf16*)(ws + WS_WA + (size_t)layer * WA_B), DM, DM, DM}; pg8::StaticOrder S; S.init(SEQ, NQKV, 1, F.G, bx);
                           pg8::EpiBf16 E{QKV, NQKV};
                           pg8::gemm_phase<pg8::EpiBf16, pg8::StaticOrder, true, true>(F.lds + RING_OFF, g, S, E); } PH_END
                PH_BEGIN attn_dilated_naive(F, QKV, AO); PH_END
                PH_BEGIN { pg8::Gemm g{AO, (const bf16*)(ws + WS_WA + (size_t)layer * WA_B + 24 * MiB), DM, DM, DM}; pg8::StaticOrder S; S.init(SEQ, DM, 1, F.G, bx);
                           pg8::EpiResid E{X, X, DM, 1.0f};
                           pg8::gemm_phase<pg8::EpiResid, pg8::StaticOrder, true, true>(F.lds + RING_OFF, g, S, E); } PH_END
            } else {
                const int jb = layer - 2;
                PH_BEGIN { pg8::Gemm g{HB, (const bf16*)(ws + WS_WB + (size_t)jb * WB_B), DM, DM, DM / 4}; pg8::StaticOrder S; S.init(SEQ, QLR, 4, F.G, bx);
                           pg8::EpiF32 E{RAW, QLR, (size_t)SEQ * QLR};
                           pg8::gemm_phase<pg8::EpiF32, pg8::StaticOrder, true, true>(F.lds + RING_OFF, g, S, E); } PH_END
                PH_BEGIN latent_post<4, QLR, false>(F, RAW, args.in[19] + (size_t)jb * QLR, CB, nullptr, ROPETAB); PH_END
                PH_BEGIN { pg8::Gemm g{CB, (const bf16*)(ws + WS_WB + (size_t)jb * WB_B + 2 * MiB), QLR, QLR, QLR}; pg8::StaticOrder S; S.init(SEQ, NQ, 1, F.G, bx);
                           pg8::EpiBf16 E{QKV, NQ};
                           pg8::gemm_phase<pg8::EpiBf16, pg8::StaticOrder, true, true>(F.lds + RING_OFF, g, S, E); } PH_END
                PH_BEGIN q_rope(F, QKV, ROPETAB); PH_END
                PH_BEGIN attn_mla_naive(F, QKV, KV, KR, AO); PH_END
                PH_BEGIN { pg8::Gemm g{AO, (const bf16*)(ws + WS_WB + (size_t)jb * WB_B + 8 * MiB), DM, DM, DM}; pg8::StaticOrder S; S.init(SEQ, DM, 1, F.G, bx);
                           pg8::EpiResid E{X, X, DM, 1.0f};
                           pg8::gemm_phase<pg8::EpiResid, pg8::StaticOrder, true, true>(F.lds + RING_OFF, g, S, E); } PH_END
            }
        }
    }
    PH_BEGIN norm_rows_f32(F, X, args.in[22], X); PH_END
#undef PH_BEGIN
#undef PH_END
}
constexpr int N_PHASES = 1 + 8 * 3 + 2 * 4 + 2 * 7 + 4 + 1;

extern "C" void kernel_launch(void* const* d_in, const int* in_sizes, int n_in, void* d_out, int out_size, void* d_ws, size_t ws_size, hipStream_t stream) {
    static int grid = 0;
    if (grid == 0) {
        if (n_in != 23 || in_sizes[0] != SEQ * DM || out_size != SEQ * DM || ws_size < WS_END) {
            fprintf(stderr, "kernel_launch: shape/workspace mismatch: n_in %d in0 %d out %d ws %zu (need %zu); nothing launched\n", n_in, n_in > 0 ? in_sizes[0] : -1, out_size, ws_size, (size_t)WS_END); grid = -1; return; }
        int dev = 0, cus = 0, per_cu = 0;
        if (hipGetDevice(&dev) != hipSuccess || hipDeviceGetAttribute(&cus, hipDeviceAttributeMultiprocessorCount, dev) != hipSuccess) { fprintf(stderr, "kernel_launch: device query failed\n"); grid = -1; return; }
        if (hipFuncSetAttribute((const void*)mk_fwd, hipFuncAttributeMaxDynamicSharedMemorySize, LDS_BYTES) != hipSuccess) { fprintf(stderr, "kernel_launch: hipFuncSetAttribute failed\n"); grid = -1; return; }
        if (hipOccupancyMaxActiveBlocksPerMultiprocessor(&per_cu, (const void*)mk_fwd, NWAVES * 64, LDS_BYTES) != hipSuccess || per_cu < 1)
            fprintf(stderr, "kernel_launch: note: occupancy query reports %d workgroups per CU\n", per_cu);
        (void)hipGetLastError();
        grid = cus;
    }
    if (grid < 0) return;
    if (hipMemsetAsync((char*)d_ws + WS_CTL, 0, CTL_ZERO_BYTES, stream) != hipSuccess) { fprintf(stderr, "kernel_launch: memset failed\n"); return; }
    Args a{};
    for (int i = 0; i < 23; ++i) a.in[i] = (const float*)d_in[i];
    a.out = (float*)d_out; a.ws = (unsigned char*)d_ws;
#if MK_PER_PHASE
    for (int p = 0; p < N_PHASES; ++p) { a.ph_lo = p; a.ph_hi = p + 1; hipLaunchKernelGGL(mk_fwd, dim3(grid), dim3(NWAVES * 64), LDS_BYTES, stream, a); }
#else
    a.ph_lo = 0; a.ph_hi = N_PHASES;
    hipLaunchKernelGGL(mk_fwd, dim3(grid), dim3(NWAVES * 64), LDS_BYTES, stream, a);
#endif
    const hipError_t le = hipPeekAtLastError();
    if (le != hipSuccess) fprintf(stderr, "kernel_launch: launch failed: %s\n", hipGetErrorName(le));
}
```

```cpp
#include <hip/hip_runtime.h>
#include <cstdio>
#include <cstdint>

#ifndef MK_PER_PHASE
#define MK_PER_PHASE 0
#endif

namespace pg8 {
#define PG8_LAS __attribute__((address_space(3)))
typedef unsigned short bf16_t;
typedef short bf16x8 __attribute__((ext_vector_type(8)));
typedef float f32x4 __attribute__((ext_vector_type(4)));
typedef float f32x2 __attribute__((ext_vector_type(2)));
typedef unsigned u32x4 __attribute__((ext_vector_type(4)));
constexpr int BM = 256, BK = 64, HALF = 128, HTB = HALF * BK * 2  , STAGE_BYTES = 8 * HTB, NXCD = 8, WGM = 8;

__host__ __device__ __forceinline__ int lds_byte(int r, int c) { const int st = (r >> 4) * 2 + (c >> 5), rr = r & 15, cc = c & 31, ob = rr * 64 + cc * 2; return st * 1024 + (ob ^ (((ob >> 9) & 1) << 5)); }
__host__ __device__ __forceinline__ void stage_rc(int b, int& R, int& C) { const int st = b / 1024, sb = b % 1024, swz = sb ^ (((sb >> 9) & 1) << 5); R = (st >> 1) * 16 + swz / 64; C = (st & 1) * 32 + (swz % 64) / 2; }
__host__ __device__ __forceinline__ int perm32(int rho) { const int n = rho >> 4, i = rho & 15; return 8 * (i >> 2) + 4 * n + (i & 3); }

struct Unit { int pm, pn, ks; };
struct Gemm { const bf16_t* A; const bf16_t* Bt; int lda, ldb, K; };

struct StaticOrder {
    int nM, nN, nS, nwg, G, c;
    __host__ __device__ void init(int M, int N, int nS_, int G_, int c_) { nM = M / BM; nN = N / BM; nS = nS_; nwg = nM * nN * nS; G = G_; c = c_; }
    __host__ __device__ bool next(int i, Unit& u) const {
        const long L = (long)i * G + c; if (L >= nwg) return false;
        int wgid = (int)L; { const int q = nwg / NXCD, r = nwg % NXCD, xcd = wgid % NXCD, off = wgid / NXCD; wgid = (xcd < r ? xcd * (q + 1) : r * (q + 1) + (xcd - r) * q) + off; }
        const int nNN = nN * nS, nig = WGM * nNN, gid = wgid / nig, fm = gid * WGM, gsz = (nM - fm) < WGM ? (nM - fm) : WGM;
        u.pm = fm + ((wgid % nig) % gsz); const int pq = (wgid % nig) / gsz; u.pn = pq % nN; u.ks = pq / nN; return true;
    }
    __device__ __forceinline__ void a_ready(const Unit&) const {}
    __device__ __forceinline__ void done(const Unit&) const {}
};

__device__ __forceinline__ unsigned cvt_pk_bf16(float lo, float hi) { unsigned r; asm volatile("v_cvt_pk_bf16_f32 %0, %1, %2" : "=v"(r) : "v"(lo), "v"(hi)); return r; }

__device__ __forceinline__ int opaque_tid() { int t; asm volatile("v_mov_b32 %0, %1" : "=v"(t) : "v"(threadIdx.x)); return t; }
struct EpiBf16 {
    static constexpr bool PERM = true, AFTER_DRAIN = false;
    bf16_t* O; int ldc;
    __device__ __forceinline__ void operator()(const f32x4 (&acc)[2][2][4][2], const Unit& u, int wr, int wc, int fr, int fq) const {
        const int row0 = u.pm * BM + wr * 64 + fr, col0 = u.pn * BM + wc * 32 + 8 * fq;
#pragma unroll
        for (int ai = 0; ai < 2; ++ai)
#pragma unroll
            for (int m = 0; m < 4; ++m) { bf16_t* rowp = O + (size_t)(row0 + ai * HALF + m * 16) * ldc + col0;
#pragma unroll
                for (int bj = 0; bj < 2; ++bj) { const f32x4 v0 = acc[ai][bj][m][0], v1 = acc[ai][bj][m][1];
                    u32x4 w; w.x = cvt_pk_bf16(v0[0], v0[1]); w.y = cvt_pk_bf16(v0[2], v0[3]); w.z = cvt_pk_bf16(v1[0], v1[1]); w.w = cvt_pk_bf16(v1[2], v1[3]);
                    *(u32x4*)(rowp + bj * HALF) = w; } }
    }
};
struct EpiSwiGLU {
    static constexpr bool PERM = true, AFTER_DRAIN = false;
    bf16_t* O; int ldc;
    __device__ __forceinline__ void operator()(const f32x4 (&acc)[2][2][4][2], const Unit& u, int wr, int wc, int fr, int fq) const {
        const int row0 = u.pm * BM + wr * 64 + fr, col0 = u.pn * HALF + wc * 32 + 8 * fq;
#pragma unroll
        for (int ai = 0; ai < 2; ++ai)
#pragma unroll
            for (int m = 0; m < 4; ++m) { bf16_t* rowp = O + (size_t)(row0 + ai * HALF + m * 16) * ldc + col0;
                float r[8];
#pragma unroll
                for (int n = 0; n < 2; ++n)
#pragma unroll
                    for (int e = 0; e < 4; ++e) { const float gv = acc[ai][0][m][n][e], uv = acc[ai][1][m][n][e];
                        const float sg = gv * __builtin_amdgcn_rcpf(1.0f + __builtin_amdgcn_exp2f(-1.4426950408889634f * gv));
                        r[n * 4 + e] = sg * uv; }
                u32x4 w; w.x = cvt_pk_bf16(r[0], r[1]); w.y = cvt_pk_bf16(r[2], r[3]); w.z = cvt_pk_bf16(r[4], r[5]); w.w = cvt_pk_bf16(r[6], r[7]);
                *(u32x4*)rowp = w; }
    }
};
struct EpiResid {
    static constexpr bool PERM = false, AFTER_DRAIN = false;
    const float* base; float* out; int ldc; float scale;
    __device__ __forceinline__ void operator()(const f32x4 (&acc)[2][2][4][2], const Unit& u, int wr, int wc, int fr, int fq) const {
        const int row0 = u.pm * BM + wr * 64 + fr, col0 = u.pn * BM + wc * 32 + 4 * fq;
#pragma unroll
        for (int ai = 0; ai < 2; ++ai)
#pragma unroll
            for (int m = 0; m < 4; ++m) { const size_t off = (size_t)(row0 + ai * HALF + m * 16) * ldc + col0;
                f32x4 b[2][2];
#pragma unroll
                for (int bj = 0; bj < 2; ++bj)
#pragma unroll
                    for (int n = 0; n < 2; ++n) b[bj][n] = *(const f32x4*)(base + off + bj * HALF + n * 16);
#pragma unroll
                for (int bj = 0; bj < 2; ++bj)
#pragma unroll
                    for (int n = 0; n < 2; ++n) *(f32x4*)(out + off + bj * HALF + n * 16) = b[bj][n] + acc[ai][bj][m][n] * scale;
            }
    }
};
struct EpiF32 {
    static constexpr bool PERM = false, AFTER_DRAIN = false;
    float* O; int ldc; size_t slice;
    __device__ __forceinline__ void operator()(const f32x4 (&acc)[2][2][4][2], const Unit& u, int wr, int wc, int fr, int fq) const {
        const int row0 = u.pm * BM + wr * 64 + fr, col0 = u.pn * BM + wc * 32 + 4 * fq; float* Ob = O + (size_t)u.ks * slice;
#pragma unroll
        for (int ai = 0; ai < 2; ++ai)
#pragma unroll
            for (int m = 0; m < 4; ++m) { const size_t off = (size_t)(row0 + ai * HALF + m * 16) * ldc + col0;
#pragma unroll
                for (int bj = 0; bj < 2; ++bj)
#pragma unroll
                    for (int n = 0; n < 2; ++n) *(f32x4*)(Ob + off + bj * HALF + n * 16) = acc[ai][bj][m][n];
            }
    }
};

template <class Epi, class Sched, bool ALIGN_EPI = false, bool SP2 = false>
__device__ __forceinline__ void gemm_phase(PG8_LAS unsigned char* lds, const Gemm g, const Sched& S, const Epi& E) {
    const int tid = opaque_tid(), wid = __builtin_amdgcn_readfirstlane(tid >> 6), lane = tid & 63, wr = wid >> 2, wc = wid & 3, fr = lane & 15, fq = lane >> 4;
    const int K = g.K, nt = K / BK;
#define PG8_UA(u) ((const char*)g.A + ((size_t)(u).pm * BM * g.lda + (size_t)(u).ks * K) * 2)
#define PG8_UB(u) ((const char*)g.Bt + ((size_t)(u).pn * BM * g.ldb + (size_t)(u).ks * K) * 2)
    unsigned voffA[2], voffB[2];
#pragma unroll
    for (int i = 0; i < 2; ++i) { int R, C; stage_rc(tid * 16 + i * 8192, R, C); const int Rb = Epi::PERM ? ((R & ~31) + perm32(R & 31)) : R;
        voffA[i] = (unsigned)(R * g.lda + C) * 2u; voffB[i] = (unsigned)(Rb * g.ldb + C) * 2u; }
    const size_t kstep = (size_t)(BK * 2);
    const size_t hstepA = (size_t)HALF * g.lda * 2, hstepB = (size_t)HALF * g.ldb * 2;
    const unsigned ldsw = (unsigned)wid * 1024u;
    const int aoff = lds_byte(wr * 64 + fr, fq * 8), boff = lds_byte(wc * 32 + fr, fq * 8);
#define PG8_SA(b, h) (((b) * 2 + (h)) * HTB)
#define PG8_SB(b, h) ((4 + (b) * 2 + (h)) * HTB)
#define PG8_STAGE(bufoff, gbase, voff) do { _Pragma("unroll") for (int _i = 0; _i < 2; ++_i) \
        __builtin_amdgcn_global_load_lds((const unsigned*)((const char*)(gbase) + (voff)[_i]), (PG8_LAS unsigned*)(lds + (bufoff) + ldsw + _i * 8192), 16, 0, 0); } while (0)
#define PG8_LDA(dst, b, h) do { _Pragma("unroll") for (int m = 0; m < 4; ++m) _Pragma("unroll") for (int k = 0; k < 2; ++k) dst[m][k] = *(const PG8_LAS bf16x8*)(lds + PG8_SA(b, h) + aoff + m * 2048 + k * 1024); } while (0)
#define PG8_LDB(dst, b, h) do { _Pragma("unroll") for (int n = 0; n < 2; ++n) _Pragma("unroll") for (int k = 0; k < 2; ++k) dst[n][k] = *(const PG8_LAS bf16x8*)(lds + PG8_SB(b, h) + boff + n * 2048 + k * 1024); } while (0)
#define PG8_MMA(ai, bj, At, Bt) do { __builtin_amdgcn_s_setprio(1); _Pragma("unroll") for (int m = 0; m < 4; ++m) _Pragma("unroll") for (int n = 0; n < 2; ++n) _Pragma("unroll") for (int k = 0; k < 2; ++k) \
        acc[ai][bj][m][n] = __builtin_amdgcn_mfma_f32_16x16x32_bf16(Bt[n][k], At[m][k], acc[ai][bj][m][n], 0, 0, 0); __builtin_amdgcn_s_setprio(0); } while (0)
#define PG8_WAIT_V(n) asm volatile("s_waitcnt vmcnt(" #n ")" ::: "memory")
#define PG8_WAIT_L(n) asm volatile("s_waitcnt lgkmcnt(" #n ")" ::: "memory")
#define PG8_BAR __builtin_amdgcn_s_barrier()
#define PG8_SCHED __builtin_amdgcn_sched_barrier(0)
    Unit cur, nxt; int ui = 0;
    if (!S.next(0, cur)) return;
    f32x4 acc[2][2][4][2];
#pragma unroll
    for (int a = 0; a < 2; ++a)
#pragma unroll
        for (int b = 0; b < 2; ++b)
#pragma unroll
            for (int m = 0; m < 4; ++m)
#pragma unroll
                for (int n = 0; n < 2; ++n) acc[a][b][m][n] = (f32x4){0.f, 0.f, 0.f, 0.f};
    bf16x8 At[4][2], B0[2][2], B1[2][2];
    const char* cA = PG8_UA(cur); const char* cB = PG8_UB(cur);
    S.a_ready(cur);
    if constexpr (SP2) {
        PG8_STAGE(PG8_SB(0, 0), cB, voffB); PG8_STAGE(PG8_SB(0, 1), cB + hstepB, voffB); PG8_STAGE(PG8_SA(0, 0), cA, voffA); PG8_STAGE(PG8_SA(0, 1), cA + hstepA, voffA);
        if (wr == 1) PG8_BAR;
        PG8_WAIT_V(2); PG8_BAR;
        PG8_STAGE(PG8_SB(1, 0), cB + kstep, voffB); PG8_STAGE(PG8_SA(1, 0), cA + kstep, voffA); PG8_STAGE(PG8_SB(1, 1), cB + hstepB + kstep, voffB);
        PG8_WAIT_V(6); PG8_BAR;
    } else {
        PG8_STAGE(PG8_SB(0, 0), cB, voffB); PG8_STAGE(PG8_SA(0, 0), cA, voffA); PG8_STAGE(PG8_SB(0, 1), cB + hstepB, voffB); PG8_STAGE(PG8_SA(0, 1), cA + hstepA, voffA);
        if (wr == 1) PG8_BAR;
        PG8_WAIT_V(4); PG8_BAR;
        PG8_STAGE(PG8_SB(1, 0), cB + kstep, voffB); PG8_STAGE(PG8_SA(1, 0), cA + kstep, voffA); PG8_STAGE(PG8_SB(1, 1), cB + hstepB + kstep, voffB);
        PG8_WAIT_V(6); PG8_BAR;
    }
    for (;;) {
        const bool has_next = S.next(ui + 1, nxt);
        const char* nA = has_next ? PG8_UA(nxt) : cA; const char* nB = has_next ? PG8_UB(nxt) : cB;
        for (int t = 0; t < nt; t += 2) {
            const bool last = (t == nt - 2);
            const char* a1 = cA + (size_t)(t + 1) * kstep;
            const char* a2 = last ? nA : cA + (size_t)(t + 2) * kstep; const char* b2 = last ? nB : cB + (size_t)(t + 2) * kstep;
            const char* a3 = a2 + kstep; const char* b3 = b2 + kstep;
            if (last && has_next) S.a_ready(nxt);
            if constexpr (SP2) {
            PG8_LDB(B0, 0, 0); PG8_LDB(B1, 0, 1); PG8_SCHED; PG8_LDA(At, 0, 0); PG8_STAGE(PG8_SA(1, 1), a1 + hstepA, voffA);
            PG8_WAIT_V(8); PG8_WAIT_L(0); PG8_BAR; PG8_MMA(0, 0, At, B0); PG8_MMA(0, 1, At, B1); PG8_BAR; PG8_SCHED;
            PG8_LDA(At, 0, 1); PG8_STAGE(PG8_SB(0, 0), b2, voffB); PG8_STAGE(PG8_SB(0, 1), b2 + hstepB, voffB); PG8_STAGE(PG8_SA(0, 0), a2, voffA);
            PG8_WAIT_V(8); PG8_WAIT_L(0); PG8_BAR; PG8_MMA(1, 0, At, B0); PG8_MMA(1, 1, At, B1); PG8_BAR; PG8_SCHED;
            PG8_LDB(B0, 1, 0); PG8_LDB(B1, 1, 1); PG8_SCHED; PG8_LDA(At, 1, 0); PG8_STAGE(PG8_SA(0, 1), a2 + hstepA, voffA);
            PG8_WAIT_V(8); PG8_WAIT_L(0); PG8_BAR; PG8_MMA(0, 0, At, B0); PG8_MMA(0, 1, At, B1); PG8_BAR; PG8_SCHED;
            PG8_LDA(At, 1, 1); PG8_STAGE(PG8_SB(1, 0), b3, voffB); PG8_STAGE(PG8_SB(1, 1), b3 + hstepB, voffB); PG8_STAGE(PG8_SA(1, 0), a3, voffA);
            PG8_WAIT_V(8); PG8_WAIT_L(0); PG8_BAR; PG8_MMA(1, 0, At, B0); PG8_MMA(1, 1, At, B1); PG8_BAR; PG8_SCHED;
            } else {
            PG8_LDB(B0, 0, 0); PG8_SCHED; PG8_LDA(At, 0, 0); PG8_STAGE(PG8_SA(1, 1), a1 + hstepA, voffA);
            PG8_WAIT_L(8); PG8_BAR; PG8_WAIT_L(0); PG8_MMA(0, 0, At, B0); PG8_BAR; PG8_SCHED;
            PG8_LDB(B1, 0, 1); PG8_STAGE(PG8_SB(0, 0), b2, voffB);
            PG8_BAR; PG8_WAIT_L(0); PG8_MMA(0, 1, At, B1); PG8_BAR;
            PG8_LDA(At, 0, 1); PG8_STAGE(PG8_SA(0, 0), a2, voffA);
            PG8_BAR; PG8_WAIT_L(0); PG8_MMA(1, 0, At, B0); PG8_BAR; PG8_SCHED;
            PG8_STAGE(PG8_SB(0, 1), b2 + hstepB, voffB);
            PG8_WAIT_V(6); PG8_BAR; PG8_MMA(1, 1, At, B1); PG8_BAR;
            PG8_LDB(B0, 1, 0); PG8_SCHED; PG8_LDA(At, 1, 0); PG8_STAGE(PG8_SA(0, 1), a2 + hstepA, voffA);
            PG8_WAIT_L(8); PG8_BAR; PG8_WAIT_L(0); PG8_MMA(0, 0, At, B0); PG8_BAR; PG8_SCHED;
            PG8_LDB(B1, 1, 1); PG8_STAGE(PG8_SB(1, 0), b3, voffB);
            PG8_BAR; PG8_WAIT_L(0); PG8_MMA(0, 1, At, B1); PG8_BAR;
            PG8_LDA(At, 1, 1); PG8_STAGE(PG8_SA(1, 0), a3, voffA);
            PG8_BAR; PG8_WAIT_L(0); PG8_MMA(1, 0, At, B0); PG8_BAR; PG8_SCHED;
            PG8_STAGE(PG8_SB(1, 1), b3 + hstepB, voffB);
            PG8_WAIT_V(6); PG8_BAR; PG8_MMA(1, 1, At, B1); PG8_BAR;
            }
        }
        if constexpr (ALIGN_EPI) { if (wr == 0) PG8_BAR; }
        if constexpr (!Epi::AFTER_DRAIN) { E(acc, cur, wr, wc, fr, fq); S.done(cur); }
        if (!has_next) break;
#pragma unroll
        for (int a = 0; a < 2; ++a)
#pragma unroll
            for (int b = 0; b < 2; ++b)
#pragma unroll
                for (int m = 0; m < 4; ++m)
#pragma unroll
                    for (int n = 0; n < 2; ++n) acc[a][b][m][n] = (f32x4){0.f, 0.f, 0.f, 0.f};
        cur = nxt; cA = nA; cB = nB; ++ui;
        if constexpr (ALIGN_EPI) { if (wr == 1) PG8_BAR; }
    }
    PG8_WAIT_V(0);
    if constexpr (!ALIGN_EPI) { if (wr == 0) PG8_BAR; }
    PG8_BAR;
    if constexpr (Epi::AFTER_DRAIN) { E.fused(acc, cur, wr, wc, fr, fq, lds, wid, lane); S.done(cur); }
#undef PG8_UA
#undef PG8_UB
#undef PG8_SA
#undef PG8_SB
#undef PG8_STAGE
#undef PG8_LDA
#undef PG8_LDB
#undef PG8_MMA
#undef PG8_WAIT_V
#undef PG8_WAIT_L
#undef PG8_BAR
#undef PG8_SCHED
}
}

#define LAS __attribute__((address_space(3)))
#define GAS __attribute__((address_space(1)))
#define XB_TMO      128
#define XB_XCNT(j)  (256  + 64 * (j))
#define XB_XSUB(j)  (1280 + 64 * (j))
#define XB_XGEN(j)  (2304 + 64 * (j))
#define XB_TOP      3328
#define XB_TOPGEN   3392
#define XCD_BAR_WORDS 3456
#define XB_SPIN_CAP (1u << 18)

__device__ __forceinline__ unsigned xb_ld(unsigned* p)              { return __hip_atomic_load(p, __ATOMIC_RELAXED, __HIP_MEMORY_SCOPE_AGENT); }
__device__ __forceinline__ unsigned xb_add(unsigned* p, unsigned v) { return __hip_atomic_fetch_add(p, v, __ATOMIC_RELAXED, __HIP_MEMORY_SCOPE_AGENT); }
__device__ __forceinline__ unsigned xb_xcc_id() { return (unsigned)__builtin_amdgcn_s_getreg((3 << 11) | 20) & 0xFu; }
#define XB_SPIN(cond, bar) do { unsigned _sp = 0; while (cond) { __builtin_amdgcn_s_sleep(1); \
    if ((++_sp & 255u) == 0u) { if (xb_ld(&(bar)[XB_TMO])) break; if (_sp > XB_SPIN_CAP) { atomicAdd(&(bar)[XB_TMO], 1u); break; } } } } while (0)

struct XcdBarrier {
    unsigned* bar; unsigned x;
    volatile LAS unsigned* st;
};

__device__ __forceinline__ XcdBarrier xcd_barrier_post(unsigned* bar, volatile LAS unsigned* st) {
    XcdBarrier b; b.bar = bar; b.x = xb_xcc_id(); b.st = st;
    if (threadIdx.x == 0) (void)xb_add(&bar[XB_XCNT(b.x)], 1u);
    return b;
}
__device__ __forceinline__ void xcd_barrier_complete(unsigned* bar, unsigned x, unsigned& nloc, unsigned& nx) {
    const unsigned G = gridDim.x * gridDim.y * gridDim.z;
    unsigned sum, cnt, mine, sp = 0u;
    for (;;) {
        sum = 0u; cnt = 0u; mine = 0u;
#pragma unroll
        for (unsigned j = 0; j < 16; ++j) { const unsigned c = xb_ld(&bar[XB_XCNT(j)]); sum += c; cnt += (c > 0u) ? 1u : 0u; mine = (j == x) ? c : mine; }
        if (sum == G) break;
        __builtin_amdgcn_s_sleep(1);
        if ((++sp & 255u) == 0u) { if (xb_ld(&bar[XB_TMO])) break; if (sp > XB_SPIN_CAP) { atomicAdd(&bar[XB_TMO], 1u); break; } }
    }
    nloc = mine > 0u ? mine : 1u; nx = cnt > 0u ? cnt : 1u;
}

__device__ __forceinline__ void xcd_barrier(const XcdBarrier& b) {
    asm volatile("s_waitcnt vmcnt(0)" ::: "memory");
    __syncthreads();
    if (threadIdx.x == 0) {
        unsigned* bar = b.bar;
        __builtin_amdgcn_s_waitcnt(0);
        unsigned nloc = b.st[0], nx = b.st[1];
        if (nloc == 0u) { xcd_barrier_complete(bar, b.x, nloc, nx); b.st[0] = nloc; b.st[1] = nx; }
        const unsigned old = xb_add(&bar[XB_XSUB(b.x)], 1u);
        const unsigned gen = old / nloc;
        if (old + 1u == (gen + 1u) * nloc) {
            __builtin_amdgcn_fence(__ATOMIC_RELEASE, "agent");
            asm volatile("s_waitcnt vmcnt(0)" ::: "memory");
            const unsigned og = xb_add(&bar[XB_TOP], 1u);
            const unsigned tg = og / nx;
            if (og + 1u == (tg + 1u) * nx) xb_add(&bar[XB_TOPGEN], 1u);
            else XB_SPIN(xb_ld(&bar[XB_TOPGEN]) == tg, bar);
            __builtin_amdgcn_fence(__ATOMIC_ACQUIRE, "agent");
            xb_add(&bar[XB_XGEN(b.x)], 1u);
            asm volatile("s_waitcnt vmcnt(0)" ::: "memory");
        } else {
            XB_SPIN(xb_ld(&bar[XB_XGEN(b.x)]) == gen, bar);
            __builtin_amdgcn_fence(__ATOMIC_ACQUIRE, "agent");
            asm volatile("s_waitcnt vmcnt(0)" ::: "memory");
        }
    }
    __syncthreads();
}

namespace fa {
typedef short bf16x8 __attribute__((ext_vector_type(8)));
typedef short s16x4 __attribute__((ext_vector_type(4)));
typedef float f32x16 __attribute__((ext_vector_type(16)));
typedef unsigned short bf16;
constexpr int SHM_V = 16384;
constexpr int V_OFF = 0;
constexpr int K_OFF = 2 * SHM_V;
constexpr int SCR_OFF = K_OFF + 2 * 24576;
constexpr float THR = 8.f;

__device__ __forceinline__ int v_rd_base(int lane) { return ((lane & 3) << 3) | (((lane >> 2) & 3) << 6) | (((lane >> 4) & 1) << 5) | (((lane >> 5) & 1) << 8); }
constexpr int v_rd_off(int d0, int ks, int half) { return d0 * 512 + ks * 4096 + half * 2048; }
__device__ __forceinline__ int crow(int r, int hi) { return (r & 3) + 8 * (r >> 2) + 4 * hi; }
__device__ __forceinline__ unsigned cvtpk(float lo, float hi) { unsigned r; asm volatile("v_cvt_pk_bf16_f32 %0, %1, %2" : "=v"(r) : "v"(lo), "v"(hi)); return r; }

template <int DQK>
__device__ __forceinline__ void qkt(f32x16& p0, f32x16& p1, const LAS unsigned char* kbuf, int r32, int hi, const bf16x8* qr) {
    p0 = f32x16{}; p1 = f32x16{};
    if constexpr (DQK == 192) {
        const int x = (r32 >> 1) & 7; const LAS unsigned char* kb[4];
#pragma unroll
        for (int e = 0; e < 4; ++e) kb[e] = kbuf + r32 * 384 + (((2 * e + hi) ^ x) << 4);
#pragma unroll
        for (int d0 = 0; d0 < 12; ++d0) { const LAS unsigned char* a = kb[d0 & 3] + (d0 >> 2) * 128;
            const bf16x8 b0 = *(const LAS bf16x8*)a, b1 = *(const LAS bf16x8*)(a + 32 * 384);
            p0 = __builtin_amdgcn_mfma_f32_32x32x16_bf16(b0, qr[d0], p0, 0, 0, 0);
            p1 = __builtin_amdgcn_mfma_f32_32x32x16_bf16(b1, qr[d0], p1, 0, 0, 0); }
    } else {
        const int x = r32 & 7; const LAS unsigned char* kb[4];
#pragma unroll
        for (int e = 0; e < 4; ++e) kb[e] = kbuf + r32 * 256 + (((2 * e + hi) ^ x) << 4);
#pragma unroll
        for (int d0 = 0; d0 < 8; ++d0) { const LAS unsigned char* a = kb[d0 & 3] + (d0 >> 2) * 128;
            const bf16x8 b0 = *(const LAS bf16x8*)a, b1 = *(const LAS bf16x8*)(a + 32 * 256);
            p0 = __builtin_amdgcn_mfma_f32_32x32x16_bf16(b0, qr[d0], p0, 0, 0, 0);
            p1 = __builtin_amdgcn_mfma_f32_32x32x16_bf16(b1, qr[d0], p1, 0, 0, 0); }
    }
}
__device__ __forceinline__ void pv_tile(f32x16* o, unsigned vb0, bf16x8 pa0, bf16x8 pa1, bf16x8 pa2, bf16x8 pa3) {
#define TRRD(dst, off) asm volatile("ds_read_b64_tr_b16 %0, %1 offset:%2" : "=&v"(dst) : "v"(vb0), "i"(off) : "memory")
#define PV_D0(d0) do { s16x4 l0, l1, l2, l3, h0, h1, h2, h3; constexpr int b_ = v_rd_off(d0, 0, 0); \
        TRRD(l0, b_); TRRD(h0, b_ + 2048); TRRD(l1, b_ + 4096); TRRD(h1, b_ + 6144); TRRD(l2, b_ + 8192); TRRD(h2, b_ + 10240); TRRD(l3, b_ + 12288); TRRD(h3, b_ + 14336); \
        asm volatile("s_waitcnt lgkmcnt(0)" ::: "memory"); __builtin_amdgcn_sched_barrier(0); \
        o[d0] = __builtin_amdgcn_mfma_f32_32x32x16_bf16(pa0, (bf16x8){l0[0], l0[1], l0[2], l0[3], h0[0], h0[1], h0[2], h0[3]}, o[d0], 0, 0, 0);   \
        o[d0] = __builtin_amdgcn_mfma_f32_32x32x16_bf16(pa1, (bf16x8){l1[0], l1[1], l1[2], l1[3], h1[0], h1[1], h1[2], h1[3]}, o[d0], 0, 0, 0);   \
        o[d0] = __builtin_amdgcn_mfma_f32_32x32x16_bf16(pa2, (bf16x8){l2[0], l2[1], l2[2], l2[3], h2[0], h2[1], h2[2], h2[3]}, o[d0], 0, 0, 0);   \
        o[d0] = __builtin_amdgcn_mfma_f32_32x32x16_bf16(pa3, (bf16x8){l3[0], l3[1], l3[2], l3[3], h3[0], h3[1], h3[2], h3[3]}, o[d0], 0, 0, 0); } while (0)
    PV_D0(0); PV_D0(1); PV_D0(2); PV_D0(3);
#undef PV_D0
#undef TRRD
}

struct UnitArgs {
    const bf16* Q; size_t qs;
    const bf16* K; size_t ks;
    const bf16* Kr; size_t krs;
    const bf16* V; size_t vs;
    bf16* O; size_t os;
    float* lse; size_t ls;
    int q0;
    int W;
    float scale;
    float bias;
};

template <int DQK, bool ALIBI>
__device__ __forceinline__ void attn_unit(LAS unsigned char* lds, const UnitArgs& u) {
    constexpr int KROW = DQK * 2, SHM_K = 64 * KROW, NKP = SHM_K / 8192, CPR = DQK / 8;
    const int tid = pg8::opaque_tid(), wid = __builtin_amdgcn_readfirstlane(tid >> 6), lane = tid & 63, r32 = lane & 31, hi = lane >> 5;
    const int W = u.W, q0 = u.q0;
    const int lowk = q0 - W + 1, j_lo = lowk > 0 ? lowk / 64 : 0, j_hi = (q0 + 255) / 64 + 1, NT = j_hi - j_lo;
    const int qlo = q0 + wid * 32;
    const float C2 = 1.4426950408889634f * u.scale;
    bf16x8 qr[DQK / 16];
    { const bf16* qp = u.Q + (size_t)(qlo + r32) * u.qs + hi * 8;
#pragma unroll
      for (int d0 = 0; d0 < DQK / 16; ++d0) qr[d0] = *(const bf16x8*)(qp + d0 * 16); }
    const char* ksrc[NKP]; size_t kstep[NKP]; const char* vsrc[2];
#pragma unroll
    for (int i = 0; i < NKP; ++i) { const int L = (wid * NKP + i) * 64 + lane, row = L / CPR, cs = L % CPR;
        const int chunk = (DQK == 192) ? (cs ^ ((row >> 1) & 7)) : (cs ^ (row & 7));
        if (DQK == 192 && chunk >= 16) { ksrc[i] = (const char*)(u.Kr + (size_t)(j_lo * 64 + row) * u.krs + (chunk - 16) * 8); kstep[i] = 64 * u.krs * 2; }
        else { ksrc[i] = (const char*)(u.K + (size_t)(j_lo * 64 + row) * u.ks + chunk * 8); kstep[i] = 64 * u.ks * 2; } }
#pragma unroll
    for (int i = 0; i < 2; ++i) { const int L = (wid * 2 + i) * 64 + lane, sub = L >> 5, rem = L & 31, kk = (sub >> 2) * 8 + (rem >> 2);
        const int k = (kk & ~0xC) | ((kk & 4) << 1) | ((kk & 8) >> 1), c = (sub & 3) * 32 + (rem & 3) * 8;
        vsrc[i] = (const char*)(u.V + (size_t)(j_lo * 64 + k) * u.vs + c); }
    const size_t vstep = 64 * u.vs * 2;
#define FA_ISSUE(buf) do { \
        _Pragma("unroll") for (int i_ = 0; i_ < NKP; ++i_) { __builtin_amdgcn_global_load_lds((const unsigned*)ksrc[i_], (LAS unsigned*)(lds + K_OFF + (buf) * SHM_K + (wid * NKP + i_) * 1024), 16, 0, 0); ksrc[i_] += kstep[i_]; } \
        _Pragma("unroll") for (int i_ = 0; i_ < 2; ++i_) { __builtin_amdgcn_global_load_lds((const unsigned*)vsrc[i_], (LAS unsigned*)(lds + V_OFF + (buf) * SHM_V + (wid * 2 + i_) * 1024), 16, 0, 0); vsrc[i_] += vstep; } } while (0)
    LAS float* scr = (LAS float*)(lds + SCR_OFF) + wid * 64; LAS float* li_l = scr; LAS float* al_l = scr + 32;
    const unsigned vbase = (unsigned)(size_t)(lds + V_OFF) + (unsigned)v_rd_base(lane);
    float m_reg = -1e30f, l_reg = 0.f; f32x16 o[4] = {};
    FA_ISSUE(0);
    for (int t = 0; t < NT; ++t) {
        asm volatile("s_waitcnt vmcnt(0)" ::: "memory"); __builtin_amdgcn_s_barrier(); asm volatile("" ::: "memory");
        const int b = t & 1;
        if (t + 1 < NT) FA_ISSUE(b ^ 1);
        const int kb = (j_lo + t) * 64;
        const bool act = (kb <= qlo + 31) && (kb + 63 >= qlo - W + 1);
        if (act) {
            f32x16 p0, p1;
            qkt<DQK>(p0, p1, lds + K_OFF + b * SHM_K, r32, hi, qr);
            const int dq = qlo + r32 - kb - 4 * hi;
            if (ALIBI) { const float dqf = (float)dq, nb = -u.bias;
#pragma unroll
                for (int r = 0; r < 16; ++r) { const float c = (float)((r & 3) + 8 * (r >> 2));
                    p0[r] = fmaf(nb, dqf - c, p0[r]); p1[r] = fmaf(nb, dqf - c - 32.f, p1[r]); } }
            if (kb + 63 > qlo || kb <= qlo + 31 - W) { const float NEG = -__builtin_inff();
#pragma unroll
                for (int r = 0; r < 16; ++r) { const int c = (r & 3) + 8 * (r >> 2);
                    if ((unsigned)(dq - c) >= (unsigned)W) p0[r] = NEG;
                    if ((unsigned)(dq - c - 32) >= (unsigned)W) p1[r] = NEG; } }
            float pmax = p0[0];
#pragma unroll
            for (int r = 1; r < 16; ++r) pmax = fmaxf(pmax, p0[r]);
#pragma unroll
            for (int r = 0; r < 16; ++r) pmax = fmaxf(pmax, p1[r]);
            { auto rr = __builtin_amdgcn_permlane32_swap(__float_as_uint(pmax), __float_as_uint(pmax), false, false);
              pmax = fmaxf(__uint_as_float(rr[0]), __uint_as_float(rr[1])); }
            float mn, alpha;
            if (__builtin_expect(__all((pmax - m_reg) * u.scale <= THR), 1)) { mn = m_reg; alpha = 1.f; }
            else { mn = fmaxf(m_reg, pmax); alpha = __builtin_amdgcn_exp2f((m_reg - mn) * C2); m_reg = mn; }
            const float mnL = -mn * C2;
#pragma unroll
            for (int r = 0; r < 16; ++r) { p0[r] = __builtin_amdgcn_exp2f(fmaf(p0[r], C2, mnL)); p1[r] = __builtin_amdgcn_exp2f(fmaf(p1[r], C2, mnL)); }
            float ps = 0.f;
#pragma unroll
            for (int r = 0; r < 16; ++r) ps += p0[r];
#pragma unroll
            for (int r = 0; r < 16; ++r) ps += p1[r];
            { auto rr = __builtin_amdgcn_permlane32_swap(__float_as_uint(ps), __float_as_uint(ps), false, false);
              ps = __uint_as_float(rr[0]) + __uint_as_float(rr[1]); }
            l_reg = l_reg * alpha + ps;
            bf16x8 pa0, pa1, pa2, pa3;
#define PK4(P, B_, OUT) do { unsigned a0 = cvtpk(P[B_+0], P[B_+1]), a1 = cvtpk(P[B_+2], P[B_+3]);                          \
        unsigned b0 = cvtpk(P[B_+4], P[B_+5]), b1 = cvtpk(P[B_+6], P[B_+7]);                                             \
        auto r0 = __builtin_amdgcn_permlane32_swap(a0, b0, false, false); auto r1 = __builtin_amdgcn_permlane32_swap(a1, b1, false, false); \
        pg8::u32x4 w = {r0[0], r1[0], r0[1], r1[1]}; OUT = __builtin_bit_cast(bf16x8, w); } while (0)
            PK4(p0, 0, pa0); PK4(p0, 8, pa1); PK4(p1, 0, pa2); PK4(p1, 8, pa3);
#undef PK4
            if (__any(alpha < 1.f)) { if (hi == 0) al_l[r32] = alpha; asm volatile("s_waitcnt lgkmcnt(0)" ::: "memory");
#pragma unroll
                for (int r = 0; r < 16; ++r) { const float a = al_l[crow(r, hi)];
#pragma unroll
                    for (int d_ = 0; d_ < 4; ++d_) o[d_][r] *= a; }
                asm volatile("s_waitcnt lgkmcnt(0)" ::: "memory"); }
            pv_tile(o, vbase + b * SHM_V, pa0, pa1, pa2, pa3);
        }
    }
#undef FA_ISSUE
    if (hi == 0) li_l[r32] = l_reg; asm volatile("s_waitcnt lgkmcnt(0)" ::: "memory");
    bf16* Ow = u.O + (size_t)qlo * u.os;
#pragma unroll
    for (int r = 0; r < 16; ++r) { const int orow = crow(r, hi); const float rl = __builtin_amdgcn_rcpf(li_l[orow]);
#pragma unroll
        for (int d0 = 0; d0 < 4; ++d0) { const float v = o[d0][r] * rl; const float vn = __shfl_xor(v, 1);
            if ((r32 & 1) == 0) *(unsigned*)(Ow + (size_t)orow * u.os + d0 * 32 + r32) = cvtpk(v, vn); } }
    if (u.lse != nullptr && hi == 0) u.lse[(size_t)(qlo + r32) * u.ls] = m_reg * u.scale + __logf(l_reg);
    asm volatile("s_waitcnt lgkmcnt(0)" ::: "memory"); __builtin_amdgcn_s_barrier(); asm volatile("" ::: "memory");
}
}

constexpr int SEQ = 8192, DM = 2048, FF = 5632, NHEAD = 16, HD = 128;
constexpr int NQKV = 3 * DM, NUP = 2 * FF;
constexpr int KVR = 512, NKV1 = 768  , NUKV = 4096, QLR = 512, NQ = NHEAD * 192;
constexpr float EPS = 1e-6f;

constexpr size_t MiB = 1u << 20;
constexpr size_t WS_CTL = 0, CTL_ZERO_BYTES = 1 * MiB;
constexpr size_t WS_ROPE = 1 * MiB;
constexpr size_t WS_W = 4 * MiB;
constexpr size_t WGU_B = (size_t)NUP * DM * 2, WD_B = (size_t)DM * FF * 2, WFFN_B = WGU_B + WD_B;
constexpr size_t WS_WA = WS_W + 8 * WFFN_B, WA_B = 32 * MiB;
constexpr size_t WS_WKV = WS_WA + 2 * WA_B;
constexpr size_t WS_WB = WS_WKV + 8 * MiB, WB_B = 16 * MiB;
constexpr size_t WS_HB = WS_WB + 2 * WB_B;
constexpr size_t WS_ACT = WS_HB + 32 * MiB;
constexpr size_t WS_QKV = WS_ACT + 88 * MiB;
constexpr size_t WS_AO = WS_QKV + 96 * MiB;
constexpr size_t WS_KV = WS_AO + 32 * MiB;
constexpr size_t WS_KR = WS_KV + 64 * MiB;
constexpr size_t WS_CB = WS_KR + 1 * MiB;
constexpr size_t WS_OG = WS_CB + 8 * MiB;
constexpr size_t WS_LSE = WS_OG + 96 * MiB;
constexpr size_t WS_END = WS_LSE + 2 * MiB;
static_assert(WGU_B == 44 * MiB && WD_B == 22 * MiB, "weight sizes");
constexpr int CW_TMO = 0, CW_BAR = 4096;

constexpr int RING_OFF = 0, RING_BYTES = 131072;
constexpr int LDSCTL_OFF = RING_BYTES, MISC_OFF = LDSCTL_OFF + 320;
constexpr int LDS_BYTES = 147456;
constexpr int NWAVES = 8;

typedef unsigned short bf16;
typedef unsigned v4u __attribute__((ext_vector_type(4)));
typedef unsigned v2u __attribute__((ext_vector_type(2)));
typedef float f32x4 __attribute__((ext_vector_type(4)));
typedef float f32x2 __attribute__((ext_vector_type(2)));
#define LDS_WAIT() asm volatile("s_waitcnt lgkmcnt(0)" ::: "memory")
#define VM_WAIT() asm volatile("s_waitcnt vmcnt(0)" ::: "memory")
__device__ __forceinline__ unsigned f2bf(float f) { unsigned u = __builtin_bit_cast(unsigned, f); return (u + 0x7fffu + ((u >> 16) & 1u)) >> 16; }
__device__ __forceinline__ unsigned pk2(float lo, float hi) { return f2bf(lo) | (f2bf(hi) << 16); }
__device__ __forceinline__ float bflo(unsigned u) { return __builtin_bit_cast(float, u << 16); }
__device__ __forceinline__ float bfhi(unsigned u) { return __builtin_bit_cast(float, u & 0xffff0000u); }
__device__ __forceinline__ float wave_sum(float v) {
#pragma unroll
    for (int o = 1; o < 64; o <<= 1) v += __shfl_xor(v, o);
    return v;
}

struct Frame { LAS unsigned char* lds; unsigned* ctl; int tid, lane, wave, G, gw, NGW; };

__device__ __forceinline__ void tr_item(const float* W, int ldw, bf16* WT, int K, int drow0, int k0, int n0, LAS float* scr, int lane) {
#pragma unroll 8
    for (int i = 0; i < 32; ++i) { const int kk = 2 * i + (lane >> 5); scr[kk * 33 + (lane & 31)] = W[(size_t)(k0 + kk) * ldw + n0 + (lane & 31)]; }
    LDS_WAIT(); asm volatile("" ::: "memory");
    const int c = lane & 7;
#pragma unroll
    for (int j = 0; j < 4; ++j) { const int n = (lane >> 3) + 8 * j; const LAS float* s = scr + (8 * c) * 33 + n;
        v4u o; o.x = pk2(s[0 * 33], s[1 * 33]); o.y = pk2(s[2 * 33], s[3 * 33]); o.z = pk2(s[4 * 33], s[5 * 33]); o.w = pk2(s[6 * 33], s[7 * 33]);
        *(v4u*)(WT + (size_t)(drow0 + n) * K + k0 + 8 * c) = o; }
    LDS_WAIT(); asm volatile("" ::: "memory");
}
__device__ __forceinline__ void tr_mat(const float* W, int K, int N, bf16* WT, int rowoff, int mode, int r, LAS float* scr, int lane) {
    const int nbk = N / 32, kb = r / nbk, nb = r % nbk, n0 = nb * 32;
    const int drow0 = rowoff + (mode ? ((n0 >> 7) * 256 + (n0 & 127)) : n0);
    tr_item(W, N, WT, K, drow0, kb * 64, n0, scr, lane);
}

struct Args { const float* in[23]; float* out; unsigned char* ws; int ph_lo, ph_hi; };

__device__ __forceinline__ void p0_prologue(const Frame& F, const Args& a) {
    LAS float* scr = (LAS float*)(F.lds + RING_OFF + F.wave * 16384);
    unsigned char* ws = a.ws;
    constexpr int I_FFN1 = (DM / 64) * (FF / 32);
    constexpr int I_FFN = 3 * I_FFN1;
    constexpr int I_QKV = (DM / 64) * (NQKV / 32), I_O = (DM / 64) * (DM / 32), I_A = I_QKV + I_O;
    constexpr int I_DKV = (DM / 64) * (KVR / 32), I_KR = (DM / 64) * (64 / 32), I_UK = (KVR / 64) * (DM / 32), I_KV = I_DKV + I_KR + 2 * I_UK;
    constexpr int I_DQ = (DM / 64) * (QLR / 32), I_UQ = (QLR / 64) * (NQ / 32), I_B = I_DQ + I_UQ + I_O;
    constexpr int NITEMS = 8 * I_FFN + 2 * I_A + I_KV + 2 * I_B;
    for (int it = F.gw; it < NITEMS; it += F.NGW) {
        int r = it;
        if (r < 8 * I_FFN) { const int s = r / I_FFN; r -= s * I_FFN; const int layer = s >> 1, which = s & 1;
            bf16* wgu = (bf16*)(ws + WS_W + (size_t)s * WFFN_B); bf16* wd = (bf16*)(ws + WS_W + (size_t)s * WFFN_B + WGU_B);
            if (r < I_FFN1) { tr_mat(a.in[which ? 7 : 2] + (size_t)layer * DM * FF, DM, FF, wgu, 0, 1, r, scr, F.lane); continue; } r -= I_FFN1;
            if (r < I_FFN1) { tr_mat(a.in[which ? 8 : 3] + (size_t)layer * DM * FF, DM, FF, wgu, 128, 1, r, scr, F.lane); continue; } r -= I_FFN1;
            tr_mat(a.in[which ? 9 : 4] + (size_t)layer * FF * DM, FF, DM, wd, 0, 0, r, scr, F.lane); continue; }
        r -= 8 * I_FFN;
        if (r < 2 * I_A) { const int l = r / I_A; r -= l * I_A;
            bf16* wqkv = (bf16*)(ws + WS_WA + (size_t)l * WA_B); bf16* wo = (bf16*)(ws + WS_WA + (size_t)l * WA_B + 24 * MiB);
            if (r < I_QKV) { tr_mat(a.in[10] + (size_t)l * DM * NQKV, DM, NQKV, wqkv, 0, 0, r, scr, F.lane); continue; } r -= I_QKV;
            tr_mat(a.in[11] + (size_t)l * DM * DM, DM, DM, wo, 0, 0, r, scr, F.lane); continue; }
        r -= 2 * I_A;
        if (r < I_KV) { bf16* wdkv = (bf16*)(ws + WS_WKV); bf16* wukv = (bf16*)(ws + WS_WKV + 3 * MiB);
            if (r < I_DKV) { tr_mat(a.in[13], DM, KVR, wdkv, 0, 0, r, scr, F.lane); continue; } r -= I_DKV;
            if (r < I_KR) { tr_mat(a.in[15], DM, 64, wdkv, KVR, 0, r, scr, F.lane); continue; } r -= I_KR;
            if (r < I_UK) { tr_mat(a.in[16], KVR, DM, wukv, 0, 0, r, scr, F.lane); continue; } r -= I_UK;
            tr_mat(a.in[17], KVR, DM, wukv, DM, 0, r, scr, F.lane); continue; }
        r -= I_KV;
        { const int l = r / I_B; r -= l * I_B;
            bf16* wdq = (bf16*)(ws + WS_WB + (size_t)l * WB_B); bf16* wuq = (bf16*)(ws + WS_WB + (size_t)l * WB_B + 2 * MiB); bf16* wo = (bf16*)(ws + WS_WB + (size_t)l * WB_B + 8 * MiB);
            if (r < I_DQ) { tr_mat(a.in[18] + (size_t)l * DM * QLR, DM, QLR, wdq, 0, 0, r, scr, F.lane); continue; } r -= I_DQ;
            if (r < I_UQ) { tr_mat(a.in[20] + (size_t)l * QLR * NQ, QLR, NQ, wuq, 0, 0, r, scr, F.lane); continue; } r -= I_UQ;
            tr_mat(a.in[21] + (size_t)l * DM * DM, DM, DM, wo, 0, 0, r, scr, F.lane); }
    }
    const int gt = blockIdx.x * (NWAVES * 64) + F.tid, NGT = F.G * NWAVES * 64;
    { v4u* z = (v4u*)(ws + WS_WKV + (size_t)576 * DM * 2); const v4u zero = {0u, 0u, 0u, 0u};
      for (int i = gt; i < (NKV1 - 576) * DM * 2 / 16; i += NGT) z[i] = zero; }
    { f32x2* tab = (f32x2*)(ws + WS_ROPE);
      for (int i = gt; i < SEQ * 32; i += NGT) { const int pos = i >> 5, j = i & 31;
          const float inv = 1.0f / exp2f((float)j * (13.287712379549449f / 32.0f));
          const float ang = (float)pos * inv;
          double t = (double)ang * 0.15915494309189535; t -= floor(t); const float tf = (float)t;
          f32x2 cs; cs.x = __builtin_amdgcn_cosf(tf); cs.y = __builtin_amdgcn_sinf(tf); tab[i] = cs; } }
}

__device__ __forceinline__ void norm_rows_bf16(const Frame& F, const float* x, const float* gain, bf16* out) {
    for (int m = F.gw; m < SEQ; m += F.NGW) {
        const f32x4* xr = (const f32x4*)(x + (size_t)m * DM) + F.lane; const f32x4* g4 = (const f32x4*)gain + F.lane;
        f32x4 v[8]; float s = 0.f;
#pragma unroll
        for (int j = 0; j < 8; ++j) { v[j] = xr[64 * j]; s += (v[j].x * v[j].x + v[j].y * v[j].y) + (v[j].z * v[j].z + v[j].w * v[j].w); }
        const float rstd = 1.0f / sqrtf(wave_sum(s) * (1.0f / DM) + EPS);
        v2u* o = (v2u*)(out + (size_t)m * DM) + F.lane;
#pragma unroll
        for (int j = 0; j < 8; ++j) { const f32x4 g = g4[64 * j]; v2u w; w.x = pk2(v[j].x * rstd * g.x, v[j].y * rstd * g.y); w.y = pk2(v[j].z * rstd * g.z, v[j].w * rstd * g.w); o[64 * j] = w; }
    }
}
__device__ __forceinline__ void norm_rows_f32(const Frame& F, const float* x, const float* gain, float* out) {
    for (int m = F.gw; m < SEQ; m += F.NGW) {
        const f32x4* xr = (const f32x4*)(x + (size_t)m * DM) + F.lane; const f32x4* g4 = (const f32x4*)gain + F.lane;
        f32x4 v[8]; float s = 0.f;
#pragma unroll
        for (int j = 0; j < 8; ++j) { v[j] = xr[64 * j]; s += (v[j].x * v[j].x + v[j].y * v[j].y) + (v[j].z * v[j].z + v[j].w * v[j].w); }
        const float rstd = 1.0f / sqrtf(wave_sum(s) * (1.0f / DM) + EPS);
        f32x4* o = (f32x4*)(out + (size_t)m * DM) + F.lane;
#pragma unroll
        for (int j = 0; j < 8; ++j) { const f32x4 g = g4[64 * j]; o[64 * j] = v[j] * rstd * g; }
    }
}
template <int NS, int LD, bool KR>
__device__ __forceinline__ void latent_post(const Frame& F, const float* raw, const float* gain, bf16* cb, bf16* kr, const f32x2* ropetab) {
    for (int m = F.gw; m < SEQ; m += F.NGW) {
        f32x4 v0 = {0.f, 0.f, 0.f, 0.f}, v1 = {0.f, 0.f, 0.f, 0.f}; float t1 = 0.f, t2 = 0.f;
#pragma unroll
        for (int p = 0; p < NS; ++p) { const float* rr = raw + (size_t)p * SEQ * LD + (size_t)m * LD;
            v0 += *(const f32x4*)(rr + 8 * F.lane); v1 += *(const f32x4*)(rr + 8 * F.lane + 4);
            if (KR) { t1 += rr[512 + (F.lane & 31)]; t2 += rr[544 + (F.lane & 31)]; } }
        const float s = (v0.x * v0.x + v0.y * v0.y) + (v0.z * v0.z + v0.w * v0.w) + (v1.x * v1.x + v1.y * v1.y) + (v1.z * v1.z + v1.w * v1.w);
        const float rstd = 1.0f / sqrtf(wave_sum(s) * (1.0f / 512.0f) + EPS);
        const f32x4 g0 = *(const f32x4*)(gain + 8 * F.lane), g1 = *(const f32x4*)(gain + 8 * F.lane + 4);
        v4u w; w.x = pk2(v0.x * rstd * g0.x, v0.y * rstd * g0.y); w.y = pk2(v0.z * rstd * g0.z, v0.w * rstd * g0.w);
        w.z = pk2(v1.x * rstd * g1.x, v1.y * rstd * g1.y); w.w = pk2(v1.z * rstd * g1.z, v1.w * rstd * g1.w);
        *(v4u*)(cb + (size_t)m * 512 + 8 * F.lane) = w;
        if (KR) { const f32x2 cs = ropetab[m * 32 + (F.lane & 31)];
            const float r = (F.lane < 32) ? (t1 * cs.x - t2 * cs.y) : (t1 * cs.y + t2 * cs.x);
            kr[(size_t)m * 64 + F.lane] = (bf16)f2bf(r); }
    }
}
__device__ __forceinline__ void q_rope(const Frame& F, bf16* q, const f32x2* ropetab) {
    for (int m = F.gw; m < SEQ; m += F.NGW) {
        bf16* qr = q + (size_t)m * NQ;
#pragma unroll
        for (int k = 0; k < 8; ++k) { const int pi = k * 64 + F.lane, h = pi >> 5, j = pi & 31;
            const f32x2 cs = ropetab[m * 32 + j];
            const float t1 = bflo(qr[h * 192 + 128 + j]), t2 = bflo(qr[h * 192 + 160 + j]);
            qr[h * 192 + 128 + j] = (bf16)f2bf(t1 * cs.x - t2 * cs.y); qr[h * 192 + 160 + j] = (bf16)f2bf(t1 * cs.y + t2 * cs.x); }
    }
}

__device__ __forceinline__ void attn_dilated_phase(LAS unsigned char* lds, const bf16* qkv, bf16* og, float* lse, int G, int bx) {
    for (int uix = bx; uix < 3 * 512; uix += G) {
        const int g = uix >> 9, rem = uix & 511, h = rem & 15, rb = rem >> 4, d = 1 << (2 * g), r = rb & (d - 1), b = rb >> (2 * g);
        const float slope = exp2f(-0.5f * (float)(h + 1)), scale = 0.08838834764831845f;
        fa::UnitArgs u;
        u.Q = qkv + (size_t)r * NQKV + h * HD; u.qs = (size_t)d * NQKV; u.K = u.Q + DM; u.ks = u.qs; u.Kr = nullptr; u.krs = 0; u.V = u.Q + 2 * DM; u.vs = u.qs;
        u.O = og + (size_t)g * SEQ * DM + (size_t)r * DM + h * HD; u.os = (size_t)d * DM; u.lse = lse + (size_t)g * SEQ * NHEAD + r * NHEAD + h; u.ls = (size_t)d * NHEAD;
        u.q0 = b * 256; u.W = 129; u.scale = scale; u.bias = slope * (float)d / scale;
        fa::attn_unit<128, true>(lds, u);
    }
}
__device__ __forceinline__ void attn_combine_phase(const Frame& F, const bf16* og, const float* lse, bf16* ao) {
    for (int p = F.gw; p < SEQ; p += F.NGW) {
#pragma unroll
        for (int j = 0; j < 4; ++j) { const int c0 = (j * 64 + F.lane) * 8, h = c0 >> 7;
            const float l0 = lse[(size_t)p * NHEAD + h], l1 = lse[(size_t)(SEQ + p) * NHEAD + h], l2 = lse[(size_t)(2 * SEQ + p) * NHEAD + h];
            const float mx = fmaxf(l0, fmaxf(l1, l2)); float w0 = __expf(l0 - mx), w1 = __expf(l1 - mx), w2 = __expf(l2 - mx);
            const float inv = 1.0f / (w0 + w1 + w2); w0 *= inv; w1 *= inv; w2 *= inv;
            const v4u a = *(const v4u*)(og + (size_t)p * DM + c0), b = *(const v4u*)(og + (size_t)(SEQ + p) * DM + c0), c = *(const v4u*)(og + (size_t)(2 * SEQ + p) * DM + c0);
            v4u o;
#pragma unroll
            for (int e = 0; e < 4; ++e) o[e] = pk2(w0 * bflo(a[e]) + w1 * bflo(b[e]) + w2 * bflo(c[e]), w0 * bfhi(a[e]) + w1 * bfhi(b[e]) + w2 * bfhi(c[e]));
            *(v4u*)(ao + (size_t)p * DM + c0) = o; }
    }
}
__device__ __forceinline__ void attn_mla_phase(LAS unsigned char* lds, const bf16* q, const bf16* kv, const bf16* kr, bf16* ao, int G, int bx) {
    for (int it = bx; it < 256; it += G) {
        const int xcd = it & 7, idx = it >> 3, h = xcd * 2 + (idx >> 4), pr = idx & 15;
        for (int pass = 0; pass < 2; ++pass) {
            fa::UnitArgs u;
            u.Q = q + h * 192; u.qs = NQ; u.K = kv + h * HD; u.ks = NUKV; u.Kr = kr; u.krs = 64; u.V = kv + DM + h * HD; u.vs = NUKV;
            u.O = ao + h * HD; u.os = DM; u.lse = nullptr; u.ls = 0; u.q0 = (pass ? 31 - pr : pr) * 256; u.W = 1 << 30; u.scale = 0.07216878364870322f; u.bias = 0.f;
            fa::attn_unit<192, false>(lds, u);
        }
    }
}

__global__ void __launch_bounds__(NWAVES * 64, 2) mk_fwd(Args args) {
    extern __shared__ __attribute__((aligned(16))) unsigned char lds_raw[];
    LAS unsigned char* const LDSB = (LAS unsigned char*)lds_raw;
    volatile LAS unsigned* MISC = (volatile LAS unsigned*)(LDSB + MISC_OFF);
    unsigned char* ws = args.ws;
    unsigned* const CTL = (unsigned*)(ws + WS_CTL);
    for (int u = threadIdx.x; u < (LDS_BYTES - LDSCTL_OFF) / 4; u += NWAVES * 64) ((LAS unsigned*)(LDSB + LDSCTL_OFF))[u] = 0u;
    __syncthreads();
    XcdBarrier bar; bar.bar = CTL + CW_BAR; bar.x = 0; bar.st = nullptr;
    if (!MK_PER_PHASE) bar = xcd_barrier_post(CTL + CW_BAR, MISC + 8);
    const int lo = args.ph_lo, hi = args.ph_hi;
    int ph = 0;
#define PH_BEGIN if (ph >= lo && ph < hi) { Frame F; F.lds = LDSB; F.ctl = CTL; F.tid = pg8::opaque_tid(); F.lane = F.tid & 63; F.wave = __builtin_amdgcn_readfirstlane(F.tid >> 6); F.G = gridDim.x; F.gw = blockIdx.x * NWAVES + F.wave; F.NGW = F.G * NWAVES;
#define PH_END } ++ph; if (!MK_PER_PHASE && ph > lo && ph < hi) xcd_barrier(bar);

    float* X = args.out;
    bf16* HB = (bf16*)(ws + WS_HB); bf16* ACT = (bf16*)(ws + WS_ACT); bf16* QKV = (bf16*)(ws + WS_QKV); bf16* AO = (bf16*)(ws + WS_AO);
    bf16* KV = (bf16*)(ws + WS_KV); bf16* KR = (bf16*)(ws + WS_KR); bf16* CB = (bf16*)(ws + WS_CB);
    float* RAW = (float*)(ws + WS_ACT); bf16* OG = (bf16*)(ws + WS_OG); float* LSE = (float*)(ws + WS_LSE);
    const f32x2* ROPETAB = (const f32x2*)(ws + WS_ROPE);
    const int bx = blockIdx.x;

    PH_BEGIN p0_prologue(F, args); PH_END

    for (int s = 0; s < 8; ++s) {
        const int layer = s >> 1, which = s & 1;
        const float* xin = (s == 0) ? args.in[0] : X;
        if (s == 4) {
            PH_BEGIN norm_rows_bf16(F, X, args.in[12], HB); PH_END
            PH_BEGIN { pg8::Gemm g{HB, (const bf16*)(ws + WS_WKV), DM, DM, DM / 2}; pg8::StaticOrder S; S.init(SEQ, NKV1, 2, F.G, bx);
                       pg8::EpiF32 E{RAW, NKV1, (size_t)SEQ * NKV1};
                       pg8::gemm_phase<pg8::EpiF32, pg8::StaticOrder, true, true>(F.lds + RING_OFF, g, S, E); } PH_END
            PH_BEGIN latent_post<2, NKV1, true>(F, RAW, args.in[14], CB, KR, ROPETAB); PH_END
            PH_BEGIN { pg8::Gemm g{CB, (const bf16*)(ws + WS_WKV + 3 * MiB), KVR, KVR, KVR}; pg8::StaticOrder S; S.init(SEQ, NUKV, 1, F.G, bx);
                       pg8::EpiBf16 E{KV, NUKV};
                       pg8::gemm_phase<pg8::EpiBf16, pg8::StaticOrder, true, true>(F.lds + RING_OFF, g, S, E); } PH_END
        }
        PH_BEGIN norm_rows_bf16(F, xin, args.in[which ? 6 : 1] + (size_t)layer * DM, HB); PH_END
        PH_BEGIN { pg8::Gemm g{HB, (const bf16*)(ws + WS_W + (size_t)s * WFFN_B), DM, DM, DM}; pg8::StaticOrder S; S.init(SEQ, NUP, 1, F.G, bx);
                   pg8::EpiSwiGLU E{ACT, FF};
                   pg8::gemm_phase<pg8::EpiSwiGLU, pg8::StaticOrder, true, true>(F.lds + RING_OFF, g, S, E); } PH_END
        PH_BEGIN { pg8::Gemm g{ACT, (const bf16*)(ws + WS_W + (size_t)s * WFFN_B + WGU_B), FF, FF, FF}; pg8::StaticOrder S; S.init(SEQ, DM, 1, F.G, bx);
                   pg8::EpiResid E{xin, X, DM, 0.5f};
                   pg8::gemm_phase<pg8::EpiResid, pg8::StaticOrder, true, true>(F.lds + RING_OFF, g, S, E); } PH_END
        if (which == 0) {
            PH_BEGIN norm_rows_bf16(F, X, args.in[5] + (size_t)layer * DM, HB); PH_END
            if (layer < 2) {
                PH_BEGIN { pg8::Gemm g{HB, (const bf16*)(ws + WS_WA + (size_t)layer * WA_B), DM, DM, DM}; pg8::StaticOrder S; S.init(SEQ, NQKV, 1, F.G, bx);
                           pg8::EpiBf16 E{QKV, NQKV};
                           pg8::gemm_phase<pg8::EpiBf16, pg8::StaticOrder, true, true>(F.lds + RING_OFF, g, S, E); } PH_END
                PH_BEGIN attn_dilated_phase(F.lds + RING_OFF, QKV, OG, LSE, F.G, bx); PH_END
                PH_BEGIN attn_combine_phase(F, OG, LSE, AO); PH_END
                PH_BEGIN { pg8::Gemm g{AO, (const bf16*)(ws + WS_WA + (size_t)layer * WA_B + 24 * MiB), DM, DM, DM}; pg8::StaticOrder S; S.init(SEQ, DM, 1, F.G, bx);
                           pg8::EpiResid E{X, X, DM, 1.0f};
                           pg8::gemm_phase<pg8::EpiResid, pg8::StaticOrder, true, true>(F.lds + RING_OFF, g, S, E); } PH_END
            } else {
                const int jb = layer - 2;
                PH_BEGIN { pg8::Gemm g{HB, (const bf16*)(ws + WS_WB + (size_t)jb * WB_B), DM, DM, DM / 4}; pg8::StaticOrder S; S.init(SEQ, QLR, 4, F.G, bx);
                           pg8::EpiF32 E{RAW, QLR, (size_t)SEQ * QLR};
                           pg8::gemm_phase<pg8::EpiF32, pg8::StaticOrder, true, true>(F.lds + RING_OFF, g, S, E); } PH_END
                PH_BEGIN latent_post<4, QLR, false>(F, RAW, args.in[19] + (size_t)jb * QLR, CB, nullptr, ROPETAB); PH_END
                PH_BEGIN { pg8::Gemm g{CB, (const bf16*)(ws + WS_WB + (size_t)jb * WB_B + 2 * MiB), QLR, QLR, QLR}; pg8::StaticOrder S; S.init(SEQ, NQ, 1, F.G, bx);
                           pg8::EpiBf16 E{QKV, NQ};
                           pg8::gemm_phase<pg8::EpiBf16, pg8::StaticOrder, true, true>(F.lds + RING_OFF, g, S, E); } PH_END
                PH_BEGIN q_rope(F, QKV, ROPETAB); PH_END
                PH_BEGIN attn_mla_phase(F.lds + RING_OFF, QKV, KV, KR, AO, F.G, bx); PH_END
                PH_BEGIN { pg8::Gemm g{AO, (const bf16*)(ws + WS_WB + (size_t)jb * WB_B + 8 * MiB), DM, DM, DM}; pg8::StaticOrder S; S.init(SEQ, DM, 1, F.G, bx);
                           pg8::EpiResid E{X, X, DM, 1.0f};
                           pg8::gemm_phase<pg8::EpiResid, pg8::StaticOrder, true, true>(F.lds + RING_OFF, g, S, E); } PH_END
            }
        }
    }
    PH_BEGIN norm_rows_f32(F, X, args.in[22], X); PH_END
#undef PH_BEGIN
#undef PH_END
}
constexpr int N_PHASES = 1 + 8 * 3 + 2 * 5 + 2 * 7 + 4 + 1;

extern "C" void kernel_launch(void* const* d_in, const int* in_sizes, int n_in, void* d_out, int out_size, void* d_ws, size_t ws_size, hipStream_t stream) {
    static int grid = 0;
    if (grid == 0) {
        if (n_in != 23 || in_sizes[0] != SEQ * DM || out_size != SEQ * DM || ws_size < WS_END) {
            fprintf(stderr, "kernel_launch: shape/workspace mismatch: n_in %d in0 %d out %d ws %zu (need %zu); nothing launched\n", n_in, n_in > 0 ? in_sizes[0] : -1, out_size, ws_size, (size_t)WS_END); grid = -1; return; }
        int dev = 0, cus = 0, per_cu = 0;
        if (hipGetDevice(&dev) != hipSuccess || hipDeviceGetAttribute(&cus, hipDeviceAttributeMultiprocessorCount, dev) != hipSuccess) { fprintf(stderr, "kernel_launch: device query failed\n"); grid = -1; return; }
        if (hipFuncSetAttribute((const void*)mk_fwd, hipFuncAttributeMaxDynamicSharedMemorySize, LDS_BYTES) != hipSuccess) { fprintf(stderr, "kernel_launch: hipFuncSetAttribute failed\n"); grid = -1; return; }
        if (hipOccupancyMaxActiveBlocksPerMultiprocessor(&per_cu, (const void*)mk_fwd, NWAVES * 64, LDS_BYTES) != hipSuccess || per_cu < 1)
            fprintf(stderr, "kernel_launch: note: occupancy query reports %d workgroups per CU\n", per_cu);
        (void)hipGetLastError();
        grid = cus;
    }
    if (grid < 0) return;
    if (hipMemsetAsync((char*)d_ws + WS_CTL, 0, CTL_ZERO_BYTES, stream) != hipSuccess) { fprintf(stderr, "kernel_launch: memset failed\n"); return; }
    Args a{};
    for (int i = 0; i < 23; ++i) a.in[i] = (const float*)d_in[i];
    a.out = (float*)d_out; a.ws = (unsigned char*)d_ws;
#if MK_PER_PHASE
    for (int p = 0; p < N_PHASES; ++p) { a.ph_lo = p; a.ph_hi = p + 1; hipLaunchKernelGGL(mk_fwd, dim3(grid), dim3(NWAVES * 64), LDS_BYTES, stream, a); }
#else
    a.ph_lo = 0; a.ph_hi = N_PHASES;
    hipLaunchKernelGGL(mk_fwd, dim3(grid), dim3(NWAVES * 64), LDS_BYTES, stream, a);
#endif
    const hipError_t le = hipPeekAtLastError();
    if (le != hipSuccess) fprintf(stderr, "kernel_launch: launch failed: %s\n", hipGetErrorName(le));
}
```

```cpp
#include <hip/hip_runtime.h>
#include <cstdio>
#include <cstdint>

#ifndef MK_PER_PHASE
#define MK_PER_PHASE 0
#endif

namespace pg8 {
#define PG8_LAS __attribute__((address_space(3)))
typedef unsigned short bf16_t;
typedef short bf16x8 __attribute__((ext_vector_type(8)));
typedef float f32x4 __attribute__((ext_vector_type(4)));
typedef float f32x2 __attribute__((ext_vector_type(2)));
typedef unsigned u32x4 __attribute__((ext_vector_type(4)));
constexpr int BM = 256, BK = 64, HALF = 128, HTB = HALF * BK * 2  , STAGE_BYTES = 8 * HTB, NXCD = 8, WGM = 8;

__host__ __device__ __forceinline__ int lds_byte(int r, int c) { const int st = (r >> 4) * 2 + (c >> 5), rr = r & 15, cc = c & 31, ob = rr * 64 + cc * 2; return st * 1024 + (ob ^ (((ob >> 9) & 1) << 5)); }
__host__ __device__ __forceinline__ void stage_rc(int b, int& R, int& C) { const int st = b / 1024, sb = b % 1024, swz = sb ^ (((sb >> 9) & 1) << 5); R = (st >> 1) * 16 + swz / 64; C = (st & 1) * 32 + (swz % 64) / 2; }
__host__ __device__ __forceinline__ int perm32(int rho) { const int n = rho >> 4, i = rho & 15; return 8 * (i >> 2) + 4 * n + (i & 3); }

struct Unit { int pm, pn, ks; };
struct Gemm { const bf16_t* A; const bf16_t* Bt; int lda, ldb, K; };

struct StaticOrder {
    int nM, nN, nS, nwg, G, c;
    __host__ __device__ void init(int M, int N, int nS_, int G_, int c_) { nM = M / BM; nN = N / BM; nS = nS_; nwg = nM * nN * nS; G = G_; c = c_; }
    __host__ __device__ __forceinline__ bool next(int i, Unit& u) const {
        const long L = (long)i * G + c; if (L >= nwg) return false;
        int wgid = (int)L; { const int q = nwg / NXCD, r = nwg % NXCD, xcd = wgid % NXCD, off = wgid / NXCD; wgid = (xcd < r ? xcd * (q + 1) : r * (q + 1) + (xcd - r) * q) + off; }
        const int nNN = nN * nS, nig = WGM * nNN, gid = wgid / nig, fm = gid * WGM, gsz = (nM - fm) < WGM ? (nM - fm) : WGM;
        u.pm = fm + ((wgid % nig) % gsz); const int pq = (wgid % nig) / gsz; u.pn = pq % nN; u.ks = pq / nN; return true;
    }
    __device__ __forceinline__ void a_ready(const Unit&) const {}
    __device__ __forceinline__ void done(const Unit&) const {}
};

__device__ __forceinline__ unsigned cvt_pk_bf16(float lo, float hi) { unsigned r; asm volatile("v_cvt_pk_bf16_f32 %0, %1, %2" : "=v"(r) : "v"(lo), "v"(hi)); return r; }

__device__ __forceinline__ int opaque_tid() { int t; asm volatile("v_mov_b32 %0, %1" : "=v"(t) : "v"(threadIdx.x)); return t; }
struct EpiBf16 {
    static constexpr bool PERM = true, AFTER_DRAIN = false;
    bf16_t* O; int ldc; const PG8_LAS float* tab; int fm256;
    __device__ __forceinline__ void operator()(const f32x4 (&acc)[2][2][4][2], const Unit& u, int wr, int wc, int fr, int fq) const {
        const int row0 = u.pm * BM + wr * 64 + fr, col0 = u.pn * BM + wc * 32 + 8 * fq;
#pragma unroll
        for (int ai = 0; ai < 2; ++ai)
#pragma unroll
            for (int m = 0; m < 4; ++m) { const int row = row0 + ai * HALF + m * 16; bf16_t* rowp = O + (size_t)row * ldc + col0;
                const float rs = tab ? tab[row - fm256] : 1.0f;
#pragma unroll
                for (int bj = 0; bj < 2; ++bj) { const f32x4 v0 = acc[ai][bj][m][0] * rs, v1 = acc[ai][bj][m][1] * rs;
                    u32x4 w; w.x = cvt_pk_bf16(v0[0], v0[1]); w.y = cvt_pk_bf16(v0[2], v0[3]); w.z = cvt_pk_bf16(v1[0], v1[1]); w.w = cvt_pk_bf16(v1[2], v1[3]);
                    *(u32x4*)(rowp + bj * HALF) = w; } }
    }
};
struct EpiSwiGLU {
    static constexpr bool PERM = true, AFTER_DRAIN = false;
    bf16_t* O; int ldc; const PG8_LAS float* tab; int fm256;
    __device__ __forceinline__ void operator()(const f32x4 (&acc)[2][2][4][2], const Unit& u, int wr, int wc, int fr, int fq) const {
        const int row0 = u.pm * BM + wr * 64 + fr, col0 = u.pn * HALF + wc * 32 + 8 * fq;
#pragma unroll
        for (int ai = 0; ai < 2; ++ai)
#pragma unroll
            for (int m = 0; m < 4; ++m) { const int row = row0 + ai * HALF + m * 16; bf16_t* rowp = O + (size_t)row * ldc + col0;
                const float rs = tab[row - fm256];
                float r[8];
#pragma unroll
                for (int n = 0; n < 2; ++n)
#pragma unroll
                    for (int e = 0; e < 4; ++e) { const float gv = acc[ai][0][m][n][e] * rs, uv = acc[ai][1][m][n][e] * rs;
                        const float sg = gv * __builtin_amdgcn_rcpf(1.0f + __builtin_amdgcn_exp2f(-1.4426950408889634f * gv));
                        r[n * 4 + e] = sg * uv; }
                u32x4 w; w.x = cvt_pk_bf16(r[0], r[1]); w.y = cvt_pk_bf16(r[2], r[3]); w.z = cvt_pk_bf16(r[4], r[5]); w.w = cvt_pk_bf16(r[6], r[7]);
                *(u32x4*)rowp = w; }
    }
};
struct EpiResidStats {
    static constexpr bool PERM = false, AFTER_DRAIN = true;
    const float* base; float* out; bf16_t* xb; float* ssq; int ldc; float scale;
    __device__ __forceinline__ void fused(const f32x4 (&acc)[2][2][4][2], const Unit& u, int wr, int wc, int fr, int fq, PG8_LAS unsigned char* lds, int wid, int lane) const {
        typedef unsigned u32x2 __attribute__((ext_vector_type(2)));
        PG8_LAS float* P = (PG8_LAS float*)lds;
        const int row0 = u.pm * BM + wr * 64 + fr, col0 = u.pn * BM + wc * 32 + 4 * fq;
#pragma unroll
        for (int ai = 0; ai < 2; ++ai)
#pragma unroll
            for (int m = 0; m < 4; ++m) { const size_t off = (size_t)(row0 + ai * HALF + m * 16) * ldc + col0;
                f32x4 b[2][2];
#pragma unroll
                for (int bj = 0; bj < 2; ++bj)
#pragma unroll
                    for (int n = 0; n < 2; ++n) b[bj][n] = *(const f32x4*)(base + off + bj * HALF + n * 16);
                float s = 0.f;
#pragma unroll
                for (int bj = 0; bj < 2; ++bj)
#pragma unroll
                    for (int n = 0; n < 2; ++n) { const f32x4 v = b[bj][n] + acc[ai][bj][m][n] * scale;
                        *(f32x4*)(out + off + bj * HALF + n * 16) = v;
                        u32x2 w; w.x = cvt_pk_bf16(v[0], v[1]); w.y = cvt_pk_bf16(v[2], v[3]); *(u32x2*)(xb + off + bj * HALF + n * 16) = w;
                        s += (v[0] * v[0] + v[1] * v[1]) + (v[2] * v[2] + v[3] * v[3]); }
                s += __shfl_xor(s, 16); s += __shfl_xor(s, 32);
                if (fq == 0) P[(ai * HALF + wr * 64 + m * 16 + fr) * 4 + wc] = s;
            }
        asm volatile("s_waitcnt lgkmcnt(0)" ::: "memory"); __builtin_amdgcn_s_barrier(); asm volatile("" ::: "memory");
        const int t = wid * 64 + lane;
        if (t < 256) { const f32x4 p = *(const PG8_LAS f32x4*)(P + t * 4); ssq[(size_t)(u.pm * BM + t) * 8 + u.pn] = (p[0] + p[1]) + (p[2] + p[3]); }
        asm volatile("s_waitcnt lgkmcnt(0)" ::: "memory"); __builtin_amdgcn_s_barrier(); asm volatile("" ::: "memory");
    }
};
struct EpiF32 {
    static constexpr bool PERM = false, AFTER_DRAIN = false;
    float* O; int ldc; size_t slice;
    __device__ __forceinline__ void operator()(const f32x4 (&acc)[2][2][4][2], const Unit& u, int wr, int wc, int fr, int fq) const {
        const int row0 = u.pm * BM + wr * 64 + fr, col0 = u.pn * BM + wc * 32 + 4 * fq; float* Ob = O + (size_t)u.ks * slice;
#pragma unroll
        for (int ai = 0; ai < 2; ++ai)
#pragma unroll
            for (int m = 0; m < 4; ++m) { const size_t off = (size_t)(row0 + ai * HALF + m * 16) * ldc + col0;
#pragma unroll
                for (int bj = 0; bj < 2; ++bj)
#pragma unroll
                    for (int n = 0; n < 2; ++n) *(f32x4*)(Ob + off + bj * HALF + n * 16) = acc[ai][bj][m][n];
            }
    }
};

template <class Epi, class Sched, bool ALIGN_EPI = false, bool SP2 = false>
__device__ __forceinline__ void gemm_phase(PG8_LAS unsigned char* lds, const Gemm g, const Sched& S, const Epi& E) {
    const int tid = opaque_tid(), wid = __builtin_amdgcn_readfirstlane(tid >> 6), lane = tid & 63, wr = wid >> 2, wc = wid & 3, fr = lane & 15, fq = lane >> 4;
    const int K = g.K, nt = K / BK;
#define PG8_UA(u) ((const char*)g.A + ((size_t)(u).pm * BM * g.lda + (size_t)(u).ks * K) * 2)
#define PG8_UB(u) ((const char*)g.Bt + ((size_t)(u).pn * BM * g.ldb + (size_t)(u).ks * K) * 2)
    unsigned voffA[2], voffB[2];
#pragma unroll
    for (int i = 0; i < 2; ++i) { int R, C; stage_rc(tid * 16 + i * 8192, R, C); const int Rb = Epi::PERM ? ((R & ~31) + perm32(R & 31)) : R;
        voffA[i] = (unsigned)(R * g.lda + C) * 2u; voffB[i] = (unsigned)(Rb * g.ldb + C) * 2u; }
    const size_t kstep = (size_t)(BK * 2);
    const size_t hstepA = (size_t)HALF * g.lda * 2, hstepB = (size_t)HALF * g.ldb * 2;
    const unsigned ldsw = (unsigned)wid * 1024u;
    const int aoff = lds_byte(wr * 64 + fr, fq * 8), boff = lds_byte(wc * 32 + fr, fq * 8);
#define PG8_SA(b, h) (((b) * 2 + (h)) * HTB)
#define PG8_SB(b, h) ((4 + (b) * 2 + (h)) * HTB)
#define PG8_STAGE(bufoff, gbase, voff) do { _Pragma("unroll") for (int _i = 0; _i < 2; ++_i) \
        __builtin_amdgcn_global_load_lds((const unsigned*)((const char*)(gbase) + (voff)[_i]), (PG8_LAS unsigned*)(lds + (bufoff) + ldsw + _i * 8192), 16, 0, 0); } while (0)
#define PG8_LDA(dst, b, h) do { _Pragma("unroll") for (int m = 0; m < 4; ++m) _Pragma("unroll") for (int k = 0; k < 2; ++k) dst[m][k] = *(const PG8_LAS bf16x8*)(lds + PG8_SA(b, h) + aoff + m * 2048 + k * 1024); } while (0)
#define PG8_LDB(dst, b, h) do { _Pragma("unroll") for (int n = 0; n < 2; ++n) _Pragma("unroll") for (int k = 0; k < 2; ++k) dst[n][k] = *(const PG8_LAS bf16x8*)(lds + PG8_SB(b, h) + boff + n * 2048 + k * 1024); } while (0)
#define PG8_MMA(ai, bj, At, Bt) do { __builtin_amdgcn_s_setprio(1); _Pragma("unroll") for (int m = 0; m < 4; ++m) _Pragma("unroll") for (int n = 0; n < 2; ++n) _Pragma("unroll") for (int k = 0; k < 2; ++k) \
        acc[ai][bj][m][n] = __builtin_amdgcn_mfma_f32_16x16x32_bf16(Bt[n][k], At[m][k], acc[ai][bj][m][n], 0, 0, 0); __builtin_amdgcn_s_setprio(0); } while (0)
#define PG8_WAIT_V(n) asm volatile("s_waitcnt vmcnt(" #n ")" ::: "memory")
#define PG8_WAIT_L(n) asm volatile("s_waitcnt lgkmcnt(" #n ")" ::: "memory")
#define PG8_BAR __builtin_amdgcn_s_barrier()
#define PG8_SCHED __builtin_amdgcn_sched_barrier(0)
    Unit cur, nxt; int ui = 0;
    if (!S.next(0, cur)) return;
    f32x4 acc[2][2][4][2];
#pragma unroll
    for (int a = 0; a < 2; ++a)
#pragma unroll
        for (int b = 0; b < 2; ++b)
#pragma unroll
            for (int m = 0; m < 4; ++m)
#pragma unroll
                for (int n = 0; n < 2; ++n) acc[a][b][m][n] = (f32x4){0.f, 0.f, 0.f, 0.f};
    bf16x8 At[4][2], B0[2][2], B1[2][2];
    const char* cA = PG8_UA(cur); const char* cB = PG8_UB(cur);
    S.a_ready(cur);
    if constexpr (SP2) {
        PG8_STAGE(PG8_SB(0, 0), cB, voffB); PG8_STAGE(PG8_SB(0, 1), cB + hstepB, voffB); PG8_STAGE(PG8_SA(0, 0), cA, voffA); PG8_STAGE(PG8_SA(0, 1), cA + hstepA, voffA);
        if (wr == 1) PG8_BAR;
        PG8_WAIT_V(2); PG8_BAR;
        PG8_STAGE(PG8_SB(1, 0), cB + kstep, voffB); PG8_STAGE(PG8_SA(1, 0), cA + kstep, voffA); PG8_STAGE(PG8_SB(1, 1), cB + hstepB + kstep, voffB);
        PG8_WAIT_V(6); PG8_BAR;
    } else {
        PG8_STAGE(PG8_SB(0, 0), cB, voffB); PG8_STAGE(PG8_SA(0, 0), cA, voffA); PG8_STAGE(PG8_SB(0, 1), cB + hstepB, voffB); PG8_STAGE(PG8_SA(0, 1), cA + hstepA, voffA);
        if (wr == 1) PG8_BAR;
        PG8_WAIT_V(4); PG8_BAR;
        PG8_STAGE(PG8_SB(1, 0), cB + kstep, voffB); PG8_STAGE(PG8_SA(1, 0), cA + kstep, voffA); PG8_STAGE(PG8_SB(1, 1), cB + hstepB + kstep, voffB);
        PG8_WAIT_V(6); PG8_BAR;
    }
    for (;;) {
        const bool has_next = S.next(ui + 1, nxt);
        const char* nA = has_next ? PG8_UA(nxt) : cA; const char* nB = has_next ? PG8_UB(nxt) : cB;
        for (int t = 0; t < nt; t += 2) {
            const bool last = (t == nt - 2);
            const char* a1 = cA + (size_t)(t + 1) * kstep;
            const char* a2 = last ? nA : cA + (size_t)(t + 2) * kstep; const char* b2 = last ? nB : cB + (size_t)(t + 2) * kstep;
            const char* a3 = a2 + kstep; const char* b3 = b2 + kstep;
            if (last && has_next) S.a_ready(nxt);
            if constexpr (SP2) {
            PG8_LDB(B0, 0, 0); PG8_LDB(B1, 0, 1); PG8_SCHED; PG8_LDA(At, 0, 0); PG8_STAGE(PG8_SA(1, 1), a1 + hstepA, voffA);
            PG8_WAIT_V(8); PG8_WAIT_L(0); PG8_BAR; PG8_MMA(0, 0, At, B0); PG8_MMA(0, 1, At, B1); PG8_BAR; PG8_SCHED;
            PG8_LDA(At, 0, 1); PG8_STAGE(PG8_SB(0, 0), b2, voffB); PG8_STAGE(PG8_SB(0, 1), b2 + hstepB, voffB); PG8_STAGE(PG8_SA(0, 0), a2, voffA);
            PG8_WAIT_V(8); PG8_WAIT_L(0); PG8_BAR; PG8_MMA(1, 0, At, B0); PG8_MMA(1, 1, At, B1); PG8_BAR; PG8_SCHED;
            PG8_LDB(B0, 1, 0); PG8_LDB(B1, 1, 1); PG8_SCHED; PG8_LDA(At, 1, 0); PG8_STAGE(PG8_SA(0, 1), a2 + hstepA, voffA);
            PG8_WAIT_V(8); PG8_WAIT_L(0); PG8_BAR; PG8_MMA(0, 0, At, B0); PG8_MMA(0, 1, At, B1); PG8_BAR; PG8_SCHED;
            PG8_LDA(At, 1, 1); PG8_STAGE(PG8_SB(1, 0), b3, voffB); PG8_STAGE(PG8_SB(1, 1), b3 + hstepB, voffB); PG8_STAGE(PG8_SA(1, 0), a3, voffA);
            PG8_WAIT_V(8); PG8_WAIT_L(0); PG8_BAR; PG8_MMA(1, 0, At, B0); PG8_MMA(1, 1, At, B1); PG8_BAR; PG8_SCHED;
            } else {
            PG8_LDB(B0, 0, 0); PG8_SCHED; PG8_LDA(At, 0, 0); PG8_STAGE(PG8_SA(1, 1), a1 + hstepA, voffA);
            PG8_WAIT_L(8); PG8_BAR; PG8_WAIT_L(0); PG8_MMA(0, 0, At, B0); PG8_BAR; PG8_SCHED;
            PG8_LDB(B1, 0, 1); PG8_STAGE(PG8_SB(0, 0), b2, voffB);
            PG8_BAR; PG8_WAIT_L(0); PG8_MMA(0, 1, At, B1); PG8_BAR;
            PG8_LDA(At, 0, 1); PG8_STAGE(PG8_SA(0, 0), a2, voffA);
            PG8_BAR; PG8_WAIT_L(0); PG8_MMA(1, 0, At, B0); PG8_BAR; PG8_SCHED;
            PG8_STAGE(PG8_SB(0, 1), b2 + hstepB, voffB);
            PG8_WAIT_V(6); PG8_BAR; PG8_MMA(1, 1, At, B1); PG8_BAR;
            PG8_LDB(B0, 1, 0); PG8_SCHED; PG8_LDA(At, 1, 0); PG8_STAGE(PG8_SA(0, 1), a2 + hstepA, voffA);
            PG8_WAIT_L(8); PG8_BAR; PG8_WAIT_L(0); PG8_MMA(0, 0, At, B0); PG8_BAR; PG8_SCHED;
            PG8_LDB(B1, 1, 1); PG8_STAGE(PG8_SB(1, 0), b3, voffB);
            PG8_BAR; PG8_WAIT_L(0); PG8_MMA(0, 1, At, B1); PG8_BAR;
            PG8_LDA(At, 1, 1); PG8_STAGE(PG8_SA(1, 0), a3, voffA);
            PG8_BAR; PG8_WAIT_L(0); PG8_MMA(1, 0, At, B0); PG8_BAR; PG8_SCHED;
            PG8_STAGE(PG8_SB(1, 1), b3 + hstepB, voffB);
            PG8_WAIT_V(6); PG8_BAR; PG8_MMA(1, 1, At, B1); PG8_BAR;
            }
        }
        if constexpr (ALIGN_EPI) { if (wr == 0) PG8_BAR; }
        if constexpr (!Epi::AFTER_DRAIN) { E(acc, cur, wr, wc, fr, fq); S.done(cur); }
        if (!has_next) break;
#pragma unroll
        for (int a = 0; a < 2; ++a)
#pragma unroll
            for (int b = 0; b < 2; ++b)
#pragma unroll
                for (int m = 0; m < 4; ++m)
#pragma unroll
                    for (int n = 0; n < 2; ++n) acc[a][b][m][n] = (f32x4){0.f, 0.f, 0.f, 0.f};
        cur = nxt; cA = nA; cB = nB; ++ui;
        if constexpr (ALIGN_EPI) { if (wr == 1) PG8_BAR; }
    }
    PG8_WAIT_V(0);
    if constexpr (!ALIGN_EPI) { if (wr == 0) PG8_BAR; }
    PG8_BAR;
    if constexpr (Epi::AFTER_DRAIN) { E.fused(acc, cur, wr, wc, fr, fq, lds, wid, lane); S.done(cur); }
#undef PG8_UA
#undef PG8_UB
#undef PG8_SA
#undef PG8_SB
#undef PG8_STAGE
#undef PG8_LDA
#undef PG8_LDB
#undef PG8_MMA
#undef PG8_WAIT_V
#undef PG8_WAIT_L
#undef PG8_BAR
#undef PG8_SCHED
}
}

#define LAS __attribute__((address_space(3)))
#define GAS __attribute__((address_space(1)))
#define XB_TMO      128
#define XB_XCNT(j)  (256  + 64 * (j))
#define XB_XSUB(j)  (1280 + 64 * (j))
#define XB_XGEN(j)  (2304 + 64 * (j))
#define XB_TOP      3328
#define XB_TOPGEN   3392
#define XCD_BAR_WORDS 3456
#define XB_SPIN_CAP (1u << 18)

__device__ __forceinline__ unsigned xb_ld(unsigned* p)              { return __hip_atomic_load(p, __ATOMIC_RELAXED, __HIP_MEMORY_SCOPE_AGENT); }
__device__ __forceinline__ unsigned xb_add(unsigned* p, unsigned v) { return __hip_atomic_fetch_add(p, v, __ATOMIC_RELAXED, __HIP_MEMORY_SCOPE_AGENT); }
__device__ __forceinline__ unsigned xb_xcc_id() { return (unsigned)__builtin_amdgcn_s_getreg((3 << 11) | 20) & 0xFu; }
#define XB_SPIN(cond, bar) do { unsigned _sp = 0; while (cond) { __builtin_amdgcn_s_sleep(1); \
    if ((++_sp & 255u) == 0u) { if (xb_ld(&(bar)[XB_TMO])) break; if (_sp > XB_SPIN_CAP) { atomicAdd(&(bar)[XB_TMO], 1u); break; } } } } while (0)

struct XcdBarrier {
    unsigned* bar; unsigned x;
    volatile LAS unsigned* st;
};

__device__ __forceinline__ XcdBarrier xcd_barrier_post(unsigned* bar, volatile LAS unsigned* st) {
    XcdBarrier b; b.bar = bar; b.x = xb_xcc_id(); b.st = st;
    if (threadIdx.x == 0) (void)xb_add(&bar[XB_XCNT(b.x)], 1u);
    return b;
}
__device__ __forceinline__ void xcd_barrier_complete(unsigned* bar, unsigned x, unsigned& nloc, unsigned& nx) {
    const unsigned G = gridDim.x * gridDim.y * gridDim.z;
    unsigned sum, cnt, mine, sp = 0u;
    for (;;) {
        sum = 0u; cnt = 0u; mine = 0u;
#pragma unroll
        for (unsigned j = 0; j < 16; ++j) { const unsigned c = xb_ld(&bar[XB_XCNT(j)]); sum += c; cnt += (c > 0u) ? 1u : 0u; mine = (j == x) ? c : mine; }
        if (sum == G) break;
        __builtin_amdgcn_s_sleep(1);
        if ((++sp & 255u) == 0u) { if (xb_ld(&bar[XB_TMO])) break; if (sp > XB_SPIN_CAP) { atomicAdd(&bar[XB_TMO], 1u); break; } }
    }
    nloc = mine > 0u ? mine : 1u; nx = cnt > 0u ? cnt : 1u;
}

__device__ __forceinline__ void xcd_barrier(const XcdBarrier& b) {
    asm volatile("s_waitcnt vmcnt(0)" ::: "memory");
    __syncthreads();
    if (threadIdx.x == 0) {
        unsigned* bar = b.bar;
        __builtin_amdgcn_s_waitcnt(0);
        unsigned nloc = b.st[0], nx = b.st[1];
        if (nloc == 0u) { xcd_barrier_complete(bar, b.x, nloc, nx); b.st[0] = nloc; b.st[1] = nx; }
        const unsigned old = xb_add(&bar[XB_XSUB(b.x)], 1u);
        const unsigned gen = old / nloc;
        if (old + 1u == (gen + 1u) * nloc) {
            __builtin_amdgcn_fence(__ATOMIC_RELEASE, "agent");
            asm volatile("s_waitcnt vmcnt(0)" ::: "memory");
            const unsigned og = xb_add(&bar[XB_TOP], 1u);
            const unsigned tg = og / nx;
            if (og + 1u == (tg + 1u) * nx) xb_add(&bar[XB_TOPGEN], 1u);
            else XB_SPIN(xb_ld(&bar[XB_TOPGEN]) == tg, bar);
            __builtin_amdgcn_fence(__ATOMIC_ACQUIRE, "agent");
            xb_add(&bar[XB_XGEN(b.x)], 1u);
            asm volatile("s_waitcnt vmcnt(0)" ::: "memory");
        } else {
            XB_SPIN(xb_ld(&bar[XB_XGEN(b.x)]) == gen, bar);
            __builtin_amdgcn_fence(__ATOMIC_ACQUIRE, "agent");
            asm volatile("s_waitcnt vmcnt(0)" ::: "memory");
        }
    }
    __syncthreads();
}

namespace fa {
typedef short bf16x8 __attribute__((ext_vector_type(8)));
typedef short s16x4 __attribute__((ext_vector_type(4)));
typedef float f32x16 __attribute__((ext_vector_type(16)));
typedef unsigned short bf16;
constexpr int SHM_V = 16384;
constexpr int V_OFF = 0;
constexpr int K_OFF = 2 * SHM_V;
constexpr int SCR_OFF = K_OFF + 2 * 24576;
constexpr float THR = 8.f;

__device__ __forceinline__ int v_rd_base(int lane) { return ((lane & 3) << 3) | (((lane >> 2) & 3) << 6) | (((lane >> 4) & 1) << 5) | (((lane >> 5) & 1) << 8); }
constexpr int v_rd_off(int d0, int ks, int half) { return d0 * 512 + ks * 4096 + half * 2048; }
__device__ __forceinline__ int crow(int r, int hi) { return (r & 3) + 8 * (r >> 2) + 4 * hi; }
__device__ __forceinline__ unsigned cvtpk(float lo, float hi) { unsigned r; asm volatile("v_cvt_pk_bf16_f32 %0, %1, %2" : "=v"(r) : "v"(lo), "v"(hi)); return r; }

template <int DQK>
__device__ __forceinline__ void qkt(f32x16& p0, f32x16& p1, const LAS unsigned char* kbuf, int r32, int hi, const bf16x8* qr) {
    p0 = f32x16{}; p1 = f32x16{};
    if constexpr (DQK == 192) {
        const int x = (r32 >> 1) & 7; const LAS unsigned char* kb[4];
#pragma unroll
        for (int e = 0; e < 4; ++e) kb[e] = kbuf + r32 * 384 + (((2 * e + hi) ^ x) << 4);
#pragma unroll
        for (int d0 = 0; d0 < 12; ++d0) { const LAS unsigned char* a = kb[d0 & 3] + (d0 >> 2) * 128;
            const bf16x8 b0 = *(const LAS bf16x8*)a, b1 = *(const LAS bf16x8*)(a + 32 * 384);
            p0 = __builtin_amdgcn_mfma_f32_32x32x16_bf16(b0, qr[d0], p0, 0, 0, 0);
            p1 = __builtin_amdgcn_mfma_f32_32x32x16_bf16(b1, qr[d0], p1, 0, 0, 0); }
    } else {
        const int x = r32 & 7; const LAS unsigned char* kb[4];
#pragma unroll
        for (int e = 0; e < 4; ++e) kb[e] = kbuf + r32 * 256 + (((2 * e + hi) ^ x) << 4);
#pragma unroll
        for (int d0 = 0; d0 < 8; ++d0) { const LAS unsigned char* a = kb[d0 & 3] + (d0 >> 2) * 128;
            const bf16x8 b0 = *(const LAS bf16x8*)a, b1 = *(const LAS bf16x8*)(a + 32 * 256);
            p0 = __builtin_amdgcn_mfma_f32_32x32x16_bf16(b0, qr[d0], p0, 0, 0, 0);
            p1 = __builtin_amdgcn_mfma_f32_32x32x16_bf16(b1, qr[d0], p1, 0, 0, 0); }
    }
}
__device__ __forceinline__ void pv_tile(f32x16* o, unsigned vb0, bf16x8 pa0, bf16x8 pa1, bf16x8 pa2, bf16x8 pa3) {
#define TRRD(dst, off) asm volatile("ds_read_b64_tr_b16 %0, %1 offset:%2" : "=&v"(dst) : "v"(vb0), "i"(off) : "memory")
#define PV_D0(d0) do { s16x4 l0, l1, l2, l3, h0, h1, h2, h3; constexpr int b_ = v_rd_off(d0, 0, 0); \
        TRRD(l0, b_); TRRD(h0, b_ + 2048); TRRD(l1, b_ + 4096); TRRD(h1, b_ + 6144); TRRD(l2, b_ + 8192); TRRD(h2, b_ + 10240); TRRD(l3, b_ + 12288); TRRD(h3, b_ + 14336); \
        asm volatile("s_waitcnt lgkmcnt(0)" ::: "memory"); __builtin_amdgcn_sched_barrier(0); \
        o[d0] = __builtin_amdgcn_mfma_f32_32x32x16_bf16(pa0, (bf16x8){l0[0], l0[1], l0[2], l0[3], h0[0], h0[1], h0[2], h0[3]}, o[d0], 0, 0, 0);   \
        o[d0] = __builtin_amdgcn_mfma_f32_32x32x16_bf16(pa1, (bf16x8){l1[0], l1[1], l1[2], l1[3], h1[0], h1[1], h1[2], h1[3]}, o[d0], 0, 0, 0);   \
        o[d0] = __builtin_amdgcn_mfma_f32_32x32x16_bf16(pa2, (bf16x8){l2[0], l2[1], l2[2], l2[3], h2[0], h2[1], h2[2], h2[3]}, o[d0], 0, 0, 0);   \
        o[d0] = __builtin_amdgcn_mfma_f32_32x32x16_bf16(pa3, (bf16x8){l3[0], l3[1], l3[2], l3[3], h3[0], h3[1], h3[2], h3[3]}, o[d0], 0, 0, 0); } while (0)
    PV_D0(0); PV_D0(1); PV_D0(2); PV_D0(3);
#undef PV_D0
#undef TRRD
}

struct UnitArgs {
    const bf16* Q; size_t qs;
    const bf16* K; size_t ks;
    const bf16* Kr; size_t krs;
    const bf16* V; size_t vs;
    bf16* O; size_t os;
    float* lse; size_t ls;
    int q0;
    int W;
    float scale;
    float bias;
};

template <int DQK, bool ALIBI>
__device__ __forceinline__ void attn_unit(LAS unsigned char* lds, const UnitArgs& u) {
    constexpr int KROW = DQK * 2, SHM_K = 64 * KROW, NKP = SHM_K / 8192, CPR = DQK / 8;
    const int tid = pg8::opaque_tid(), wid = __builtin_amdgcn_readfirstlane(tid >> 6), lane = tid & 63, r32 = lane & 31, hi = lane >> 5;
    const int W = u.W, q0 = u.q0;
    const int lowk = q0 - W + 1, j_lo = lowk > 0 ? lowk / 64 : 0, j_hi = (q0 + 255) / 64 + 1, NT = j_hi - j_lo;
    const int qlo = q0 + wid * 32;
    const float C2 = 1.4426950408889634f * u.scale;
    bf16x8 qr[DQK / 16];
    { const bf16* qp = u.Q + (size_t)(qlo + r32) * u.qs + hi * 8;
#pragma unroll
      for (int d0 = 0; d0 < DQK / 16; ++d0) qr[d0] = *(const bf16x8*)(qp + d0 * 16); }
    const char* ksrc[NKP]; size_t kstep[NKP]; const char* vsrc[2];
#pragma unroll
    for (int i = 0; i < NKP; ++i) { const int L = (wid * NKP + i) * 64 + lane, row = L / CPR, cs = L % CPR;
        const int chunk = (DQK == 192) ? (cs ^ ((row >> 1) & 7)) : (cs ^ (row & 7));
        if (DQK == 192 && chunk >= 16) { ksrc[i] = (const char*)(u.Kr + (size_t)(j_lo * 64 + row) * u.krs + (chunk - 16) * 8); kstep[i] = 64 * u.krs * 2; }
        else { ksrc[i] = (const char*)(u.K + (size_t)(j_lo * 64 + row) * u.ks + chunk * 8); kstep[i] = 64 * u.ks * 2; } }
#pragma unroll
    for (int i = 0; i < 2; ++i) { const int L = (wid * 2 + i) * 64 + lane, sub = L >> 5, rem = L & 31, kk = (sub >> 2) * 8 + (rem >> 2);
        const int k = (kk & ~0xC) | ((kk & 4) << 1) | ((kk & 8) >> 1), c = (sub & 3) * 32 + (rem & 3) * 8;
        vsrc[i] = (const char*)(u.V + (size_t)(j_lo * 64 + k) * u.vs + c); }
    const size_t vstep = 64 * u.vs * 2;
#define FA_ISSUE(buf) do { \
        _Pragma("unroll") for (int i_ = 0; i_ < NKP; ++i_) { __builtin_amdgcn_global_load_lds((const unsigned*)ksrc[i_], (LAS unsigned*)(lds + K_OFF + (buf) * SHM_K + (wid * NKP + i_) * 1024), 16, 0, 0); ksrc[i_] += kstep[i_]; } \
        _Pragma("unroll") for (int i_ = 0; i_ < 2; ++i_) { __builtin_amdgcn_global_load_lds((const unsigned*)vsrc[i_], (LAS unsigned*)(lds + V_OFF + (buf) * SHM_V + (wid * 2 + i_) * 1024), 16, 0, 0); vsrc[i_] += vstep; } } while (0)
    LAS float* scr = (LAS float*)(lds + SCR_OFF) + wid * 64; LAS float* li_l = scr; LAS float* al_l = scr + 32;
    const unsigned vbase = (unsigned)(size_t)(lds + V_OFF) + (unsigned)v_rd_base(lane);
    float m_reg = -1e30f, l_reg = 0.f; f32x16 o[4] = {};
    FA_ISSUE(0);
    for (int t = 0; t < NT; ++t) {
        asm volatile("s_waitcnt vmcnt(0)" ::: "memory"); __builtin_amdgcn_s_barrier(); asm volatile("" ::: "memory");
        const int b = t & 1;
        if (t + 1 < NT) FA_ISSUE(b ^ 1);
        const int kb = (j_lo + t) * 64;
        const bool act = (kb <= qlo + 31) && (kb + 63 >= qlo - W + 1);
        if (act) {
            f32x16 p0, p1;
            qkt<DQK>(p0, p1, lds + K_OFF + b * SHM_K, r32, hi, qr);
            const int dq = qlo + r32 - kb - 4 * hi;
            if (ALIBI) { const float dqf = (float)dq, nb = -u.bias;
#pragma unroll
                for (int r = 0; r < 16; ++r) { const float c = (float)((r & 3) + 8 * (r >> 2));
                    p0[r] = fmaf(nb, dqf - c, p0[r]); p1[r] = fmaf(nb, dqf - c - 32.f, p1[r]); } }
            if (kb + 63 > qlo || kb <= qlo + 31 - W) { const float NEG = -__builtin_inff();
#pragma unroll
                for (int r = 0; r < 16; ++r) { const int c = (r & 3) + 8 * (r >> 2);
                    if ((unsigned)(dq - c) >= (unsigned)W) p0[r] = NEG;
                    if ((unsigned)(dq - c - 32) >= (unsigned)W) p1[r] = NEG; } }
            float pmax = p0[0];
#pragma unroll
            for (int r = 1; r < 16; ++r) pmax = fmaxf(pmax, p0[r]);
#pragma unroll
            for (int r = 0; r < 16; ++r) pmax = fmaxf(pmax, p1[r]);
            { auto rr = __builtin_amdgcn_permlane32_swap(__float_as_uint(pmax), __float_as_uint(pmax), false, false);
              pmax = fmaxf(__uint_as_float(rr[0]), __uint_as_float(rr[1])); }
            float mn, alpha;
            if (__builtin_expect(__all((pmax - m_reg) * u.scale <= THR), 1)) { mn = m_reg; alpha = 1.f; }
            else { mn = fmaxf(m_reg, pmax); alpha = __builtin_amdgcn_exp2f((m_reg - mn) * C2); m_reg = mn; }
            const float mnL = -mn * C2;
#pragma unroll
            for (int r = 0; r < 16; ++r) { p0[r] = __builtin_amdgcn_exp2f(fmaf(p0[r], C2, mnL)); p1[r] = __builtin_amdgcn_exp2f(fmaf(p1[r], C2, mnL)); }
            float ps = 0.f;
#pragma unroll
            for (int r = 0; r < 16; ++r) ps += p0[r];
#pragma unroll
            for (int r = 0; r < 16; ++r) ps += p1[r];
            { auto rr = __builtin_amdgcn_permlane32_swap(__float_as_uint(ps), __float_as_uint(ps), false, false);
              ps = __uint_as_float(rr[0]) + __uint_as_float(rr[1]); }
            l_reg = l_reg * alpha + ps;
            bf16x8 pa0, pa1, pa2, pa3;
#define PK4(P, B_, OUT) do { unsigned a0 = cvtpk(P[B_+0], P[B_+1]), a1 = cvtpk(P[B_+2], P[B_+3]);                          \
        unsigned b0 = cvtpk(P[B_+4], P[B_+5]), b1 = cvtpk(P[B_+6], P[B_+7]);                                             \
        auto r0 = __builtin_amdgcn_permlane32_swap(a0, b0, false, false); auto r1 = __builtin_amdgcn_permlane32_swap(a1, b1, false, false); \
        pg8::u32x4 w = {r0[0], r1[0], r0[1], r1[1]}; OUT = __builtin_bit_cast(bf16x8, w); } while (0)
            PK4(p0, 0, pa0); PK4(p0, 8, pa1); PK4(p1, 0, pa2); PK4(p1, 8, pa3);
#undef PK4
            if (__any(alpha < 1.f)) { if (hi == 0) al_l[r32] = alpha; asm volatile("s_waitcnt lgkmcnt(0)" ::: "memory");
#pragma unroll
                for (int r = 0; r < 16; ++r) { const float a = al_l[crow(r, hi)];
#pragma unroll
                    for (int d_ = 0; d_ < 4; ++d_) o[d_][r] *= a; }
                asm volatile("s_waitcnt lgkmcnt(0)" ::: "memory"); }
            pv_tile(o, vbase + b * SHM_V, pa0, pa1, pa2, pa3);
        }
    }
#undef FA_ISSUE
    if (hi == 0) li_l[r32] = l_reg; asm volatile("s_waitcnt lgkmcnt(0)" ::: "memory");
    bf16* Ow = u.O + (size_t)qlo * u.os;
#pragma unroll
    for (int r = 0; r < 16; ++r) { const int orow = crow(r, hi); const float rl = __builtin_amdgcn_rcpf(li_l[orow]);
#pragma unroll
        for (int d0 = 0; d0 < 4; ++d0) { const float v = o[d0][r] * rl; const float vn = __shfl_xor(v, 1);
            if ((r32 & 1) == 0) *(unsigned*)(Ow + (size_t)orow * u.os + d0 * 32 + r32) = cvtpk(v, vn); } }
    if (u.lse != nullptr && hi == 0) u.lse[(size_t)(qlo + r32) * u.ls] = m_reg * u.scale + __logf(l_reg);
    asm volatile("s_waitcnt lgkmcnt(0)" ::: "memory"); __builtin_amdgcn_s_barrier(); asm volatile("" ::: "memory");
}
}

constexpr int SEQ = 8192, DM = 2048, FF = 5632, NHEAD = 16, HD = 128;
constexpr int NQKV = 3 * DM, NUP = 2 * FF;
constexpr int KVR = 512, NKV1 = 768  , NUKV = 4096, QLR = 512, NQ = NHEAD * 192;
constexpr float EPS = 1e-6f;

constexpr size_t MiB = 1u << 20;
constexpr size_t WS_CTL = 0, CTL_ZERO_BYTES = 1 * MiB;
constexpr size_t WS_ROPE = 1 * MiB;
constexpr size_t WS_W = 4 * MiB;
constexpr size_t WGU_B = (size_t)NUP * DM * 2, WD_B = (size_t)DM * FF * 2, WFFN_B = WGU_B + WD_B;
constexpr size_t WS_WA = WS_W + 8 * WFFN_B, WA_B = 32 * MiB;
constexpr size_t WS_WKV = WS_WA + 2 * WA_B;
constexpr size_t WS_WB = WS_WKV + 8 * MiB, WB_B = 16 * MiB;
constexpr size_t WS_HB = WS_WB + 2 * WB_B;
constexpr size_t WS_ACT = WS_HB + 32 * MiB;
constexpr size_t WS_QKV = WS_ACT + 88 * MiB;
constexpr size_t WS_AO = WS_QKV + 96 * MiB;
constexpr size_t WS_KV = WS_AO + 32 * MiB;
constexpr size_t WS_KR = WS_KV + 64 * MiB;
constexpr size_t WS_CB = WS_KR + 1 * MiB;
constexpr size_t WS_OG = WS_CB + 8 * MiB;
constexpr size_t WS_LSE = WS_OG + 96 * MiB;
constexpr size_t WS_SSQ = WS_LSE + 2 * MiB;
constexpr size_t WS_END = WS_SSQ + 1 * MiB;
static_assert(WGU_B == 44 * MiB && WD_B == 22 * MiB, "weight sizes");
constexpr int CW_TMO = 0, CW_BAR = 4096;

constexpr int RING_OFF = 0, RING_BYTES = 131072;
constexpr int LDSCTL_OFF = RING_BYTES, MISC_OFF = LDSCTL_OFF + 320;
constexpr int TAB_OFF = RING_BYTES + 1024;
constexpr int LDS_BYTES = 147456;
constexpr int NWAVES = 8;

typedef unsigned short bf16;
typedef unsigned v4u __attribute__((ext_vector_type(4)));
typedef unsigned v2u __attribute__((ext_vector_type(2)));
typedef float f32x4 __attribute__((ext_vector_type(4)));
typedef float f32x2 __attribute__((ext_vector_type(2)));
#define LDS_WAIT() asm volatile("s_waitcnt lgkmcnt(0)" ::: "memory")
#define VM_WAIT() asm volatile("s_waitcnt vmcnt(0)" ::: "memory")
__device__ __forceinline__ unsigned f2bf(float f) { unsigned u = __builtin_bit_cast(unsigned, f); return (u + 0x7fffu + ((u >> 16) & 1u)) >> 16; }
__device__ __forceinline__ unsigned pk2(float lo, float hi) { return f2bf(lo) | (f2bf(hi) << 16); }
__device__ __forceinline__ float bflo(unsigned u) { return __builtin_bit_cast(float, u << 16); }
__device__ __forceinline__ float bfhi(unsigned u) { return __builtin_bit_cast(float, u & 0xffff0000u); }
__device__ __forceinline__ float wave_sum(float v) {
#pragma unroll
    for (int o = 1; o < 64; o <<= 1) v += __shfl_xor(v, o);
    return v;
}

struct Frame { LAS unsigned char* lds; unsigned* ctl; int tid, lane, wave, G, gw, NGW; };

__device__ __forceinline__ void tr_item(const float* W, int ldw, bf16* WT, int K, int drow0, int k0, int n0, LAS float* scr, int lane, const float* gain) {
#pragma unroll 8
    for (int i = 0; i < 32; ++i) { const int kk = 2 * i + (lane >> 5); scr[kk * 33 + (lane & 31)] = W[(size_t)(k0 + kk) * ldw + n0 + (lane & 31)]; }
    LDS_WAIT(); asm volatile("" ::: "memory");
    const int c = lane & 7;
    f32x4 g0 = {1.f, 1.f, 1.f, 1.f}, g1 = {1.f, 1.f, 1.f, 1.f};
    if (gain) { g0 = *(const f32x4*)(gain + k0 + 8 * c); g1 = *(const f32x4*)(gain + k0 + 8 * c + 4); }
#pragma unroll
    for (int j = 0; j < 4; ++j) { const int n = (lane >> 3) + 8 * j; const LAS float* s = scr + (8 * c) * 33 + n;
        v4u o; o.x = pk2(s[0 * 33] * g0.x, s[1 * 33] * g0.y); o.y = pk2(s[2 * 33] * g0.z, s[3 * 33] * g0.w); o.z = pk2(s[4 * 33] * g1.x, s[5 * 33] * g1.y); o.w = pk2(s[6 * 33] * g1.z, s[7 * 33] * g1.w);
        *(v4u*)(WT + (size_t)(drow0 + n) * K + k0 + 8 * c) = o; }
    LDS_WAIT(); asm volatile("" ::: "memory");
}
__device__ __forceinline__ void tr_mat(const float* W, int K, int N, bf16* WT, int rowoff, int mode, int r, LAS float* scr, int lane, const float* gain) {
    const int nbk = N / 32, kb = r / nbk, nb = r % nbk, n0 = nb * 32;
    const int drow0 = rowoff + (mode ? ((n0 >> 7) * 256 + (n0 & 127)) : n0);
    tr_item(W, N, WT, K, drow0, kb * 64, n0, scr, lane, gain);
}

struct Args { const float* in[23]; float* out; unsigned char* ws; int ph_lo, ph_hi; };

__device__ __forceinline__ void p0_prologue(const Frame& F, const Args& a) {
    LAS float* scr = (LAS float*)(F.lds + RING_OFF + F.wave * 16384);
    unsigned char* ws = a.ws;
    constexpr int I_FFN1 = (DM / 64) * (FF / 32);
    constexpr int I_FFN = 3 * I_FFN1;
    constexpr int I_QKV = (DM / 64) * (NQKV / 32), I_O = (DM / 64) * (DM / 32), I_A = I_QKV + I_O;
    constexpr int I_DKV = (DM / 64) * (KVR / 32), I_KR = (DM / 64) * (64 / 32), I_UK = (KVR / 64) * (DM / 32), I_KV = I_DKV + I_KR + 2 * I_UK;
    constexpr int I_DQ = (DM / 64) * (QLR / 32), I_UQ = (QLR / 64) * (NQ / 32), I_B = I_DQ + I_UQ + I_O;
    constexpr int NITEMS = 8 * I_FFN + 2 * I_A + I_KV + 2 * I_B;
    for (int it = F.gw; it < NITEMS; it += F.NGW) {
        int r = it;
        if (r < 8 * I_FFN) { const int s = r / I_FFN; r -= s * I_FFN; const int layer = s >> 1, which = s & 1;
            bf16* wgu = (bf16*)(ws + WS_W + (size_t)s * WFFN_B); bf16* wd = (bf16*)(ws + WS_W + (size_t)s * WFFN_B + WGU_B);
            if (r < I_FFN1) { tr_mat(a.in[which ? 7 : 2] + (size_t)layer * DM * FF, DM, FF, wgu, 0, 1, r, scr, F.lane, a.in[which ? 6 : 1] + (size_t)layer * DM); continue; } r -= I_FFN1;
            if (r < I_FFN1) { tr_mat(a.in[which ? 8 : 3] + (size_t)layer * DM * FF, DM, FF, wgu, 128, 1, r, scr, F.lane, a.in[which ? 6 : 1] + (size_t)layer * DM); continue; } r -= I_FFN1;
            tr_mat(a.in[which ? 9 : 4] + (size_t)layer * FF * DM, FF, DM, wd, 0, 0, r, scr, F.lane, nullptr); continue; }
        r -= 8 * I_FFN;
        if (r < 2 * I_A) { const int l = r / I_A; r -= l * I_A;
            bf16* wqkv = (bf16*)(ws + WS_WA + (size_t)l * WA_B); bf16* wo = (bf16*)(ws + WS_WA + (size_t)l * WA_B + 24 * MiB);
            if (r < I_QKV) { tr_mat(a.in[10] + (size_t)l * DM * NQKV, DM, NQKV, wqkv, 0, 0, r, scr, F.lane, a.in[5] + (size_t)l * DM); continue; } r -= I_QKV;
            tr_mat(a.in[11] + (size_t)l * DM * DM, DM, DM, wo, 0, 0, r, scr, F.lane, nullptr); continue; }
        r -= 2 * I_A;
        if (r < I_KV) { bf16* wdkv = (bf16*)(ws + WS_WKV); bf16* wukv = (bf16*)(ws + WS_WKV + 3 * MiB);
            if (r < I_DKV) { tr_mat(a.in[13], DM, KVR, wdkv, 0, 0, r, scr, F.lane, a.in[12]); continue; } r -= I_DKV;
            if (r < I_KR) { tr_mat(a.in[15], DM, 64, wdkv, KVR, 0, r, scr, F.lane, a.in[12]); continue; } r -= I_KR;
            if (r < I_UK) { tr_mat(a.in[16], KVR, DM, wukv, 0, 0, r, scr, F.lane, nullptr); continue; } r -= I_UK;
            tr_mat(a.in[17], KVR, DM, wukv, DM, 0, r, scr, F.lane, nullptr); continue; }
        r -= I_KV;
        { const int l = r / I_B; r -= l * I_B;
            bf16* wdq = (bf16*)(ws + WS_WB + (size_t)l * WB_B); bf16* wuq = (bf16*)(ws + WS_WB + (size_t)l * WB_B + 2 * MiB); bf16* wo = (bf16*)(ws + WS_WB + (size_t)l * WB_B + 8 * MiB);
            if (r < I_DQ) { tr_mat(a.in[18] + (size_t)l * DM * QLR, DM, QLR, wdq, 0, 0, r, scr, F.lane, a.in[5] + (size_t)(2 + l) * DM); continue; } r -= I_DQ;
            if (r < I_UQ) { tr_mat(a.in[20] + (size_t)l * QLR * NQ, QLR, NQ, wuq, 0, 0, r, scr, F.lane, nullptr); continue; } r -= I_UQ;
            tr_mat(a.in[21] + (size_t)l * DM * DM, DM, DM, wo, 0, 0, r, scr, F.lane, nullptr); }
    }
    const int gt = blockIdx.x * (NWAVES * 64) + F.tid, NGT = F.G * NWAVES * 64;
    { v4u* z = (v4u*)(ws + WS_WKV + (size_t)576 * DM * 2); const v4u zero = {0u, 0u, 0u, 0u};
      for (int i = gt; i < (NKV1 - 576) * DM * 2 / 16; i += NGT) z[i] = zero; }
    { f32x2* tab = (f32x2*)(ws + WS_ROPE);
      for (int i = gt; i < SEQ * 32; i += NGT) { const int pos = i >> 5, j = i & 31;
          const float inv = 1.0f / exp2f((float)j * (13.287712379549449f / 32.0f));
          const float ang = (float)pos * inv;
          double t = (double)ang * 0.15915494309189535; t -= floor(t); const float tf = (float)t;
          f32x2 cs; cs.x = __builtin_amdgcn_cosf(tf); cs.y = __builtin_amdgcn_sinf(tf); tab[i] = cs; } }
    { bf16* xb = (bf16*)(ws + WS_HB); float* ssq = (float*)(ws + WS_SSQ); const float* x = a.in[0];
      for (int m = F.gw; m < SEQ; m += F.NGW) {
          const f32x4* xr = (const f32x4*)(x + (size_t)m * DM) + F.lane; v2u* o = (v2u*)(xb + (size_t)m * DM) + F.lane; float s = 0.f;
#pragma unroll
          for (int j = 0; j < 8; ++j) { const f32x4 v = xr[64 * j]; s += (v.x * v.x + v.y * v.y) + (v.z * v.z + v.w * v.w); v2u w; w.x = pk2(v.x, v.y); w.y = pk2(v.z, v.w); o[64 * j] = w; }
          s = wave_sum(s);
          if (F.lane < 8) ssq[(size_t)m * 8 + F.lane] = (F.lane == 0) ? s : 0.f; } }
}
__device__ __forceinline__ void fill_rstd_tab(const Frame& F, const float* ssq, int fm256) {
    LAS float* tab = (LAS float*)(F.lds + TAB_OFF);
    for (int i = F.tid; i < 2048; i += NWAVES * 64) { const f32x4 a = *(const f32x4*)(ssq + (size_t)(fm256 + i) * 8), b = *(const f32x4*)(ssq + (size_t)(fm256 + i) * 8 + 4);
        const float s = ((a.x + a.y) + (a.z + a.w)) + ((b.x + b.y) + (b.z + b.w)); tab[i] = 1.0f / sqrtf(s * (1.0f / DM) + EPS); }
    __syncthreads();
}

__device__ __forceinline__ void norm_rows_bf16(const Frame& F, const float* x, const float* gain, bf16* out) {
    for (int m = F.gw; m < SEQ; m += F.NGW) {
        const f32x4* xr = (const f32x4*)(x + (size_t)m * DM) + F.lane; const f32x4* g4 = (const f32x4*)gain + F.lane;
        f32x4 v[8]; float s = 0.f;
#pragma unroll
        for (int j = 0; j < 8; ++j) { v[j] = xr[64 * j]; s += (v[j].x * v[j].x + v[j].y * v[j].y) + (v[j].z * v[j].z + v[j].w * v[j].w); }
        const float rstd = 1.0f / sqrtf(wave_sum(s) * (1.0f / DM) + EPS);
        v2u* o = (v2u*)(out + (size_t)m * DM) + F.lane;
#pragma unroll
        for (int j = 0; j < 8; ++j) { const f32x4 g = g4[64 * j]; v2u w; w.x = pk2(v[j].x * rstd * g.x, v[j].y * rstd * g.y); w.y = pk2(v[j].z * rstd * g.z, v[j].w * rstd * g.w); o[64 * j] = w; }
    }
}
__device__ __forceinline__ void norm_rows_f32(const Frame& F, const float* x, const float* gain, float* out) {
    for (int m = F.gw; m < SEQ; m += F.NGW) {
        const f32x4* xr = (const f32x4*)(x + (size_t)m * DM) + F.lane; const f32x4* g4 = (const f32x4*)gain + F.lane;
        f32x4 v[8]; float s = 0.f;
#pragma unroll
        for (int j = 0; j < 8; ++j) { v[j] = xr[64 * j]; s += (v[j].x * v[j].x + v[j].y * v[j].y) + (v[j].z * v[j].z + v[j].w * v[j].w); }
        const float rstd = 1.0f / sqrtf(wave_sum(s) * (1.0f / DM) + EPS);
        f32x4* o = (f32x4*)(out + (size_t)m * DM) + F.lane;
#pragma unroll
        for (int j = 0; j < 8; ++j) { const f32x4 g = g4[64 * j]; o[64 * j] = v[j] * rstd * g; }
    }
}
template <int NS, int LD, bool KR>
__device__ __forceinline__ void latent_post(const Frame& F, const float* raw, const float* gain, bf16* cb, bf16* kr, const f32x2* ropetab, const float* ssq) {
    for (int m = F.gw; m < SEQ; m += F.NGW) {
        f32x4 v0 = {0.f, 0.f, 0.f, 0.f}, v1 = {0.f, 0.f, 0.f, 0.f}; float t1 = 0.f, t2 = 0.f;
        const f32x4 qa = *(const f32x4*)(ssq + (size_t)m * 8), qb = *(const f32x4*)(ssq + (size_t)m * 8 + 4);
        const float rsx = 1.0f / sqrtf((((qa.x + qa.y) + (qa.z + qa.w)) + ((qb.x + qb.y) + (qb.z + qb.w))) * (1.0f / DM) + EPS);
#pragma unroll
        for (int p = 0; p < NS; ++p) { const float* rr = raw + (size_t)p * SEQ * LD + (size_t)m * LD;
            v0 += *(const f32x4*)(rr + 8 * F.lane); v1 += *(const f32x4*)(rr + 8 * F.lane + 4);
            if (KR) { t1 += rr[512 + (F.lane & 31)]; t2 += rr[544 + (F.lane & 31)]; } }
        v0 *= rsx; v1 *= rsx; t1 *= rsx; t2 *= rsx;
        const float s = (v0.x * v0.x + v0.y * v0.y) + (v0.z * v0.z + v0.w * v0.w) + (v1.x * v1.x + v1.y * v1.y) + (v1.z * v1.z + v1.w * v1.w);
        const float rstd = 1.0f / sqrtf(wave_sum(s) * (1.0f / 512.0f) + EPS);
        const f32x4 g0 = *(const f32x4*)(gain + 8 * F.lane), g1 = *(const f32x4*)(gain + 8 * F.lane + 4);
        v4u w; w.x = pk2(v0.x * rstd * g0.x, v0.y * rstd * g0.y); w.y = pk2(v0.z * rstd * g0.z, v0.w * rstd * g0.w);
        w.z = pk2(v1.x * rstd * g1.x, v1.y * rstd * g1.y); w.w = pk2(v1.z * rstd * g1.z, v1.w * rstd * g1.w);
        *(v4u*)(cb + (size_t)m * 512 + 8 * F.lane) = w;
        if (KR) { const f32x2 cs = ropetab[m * 32 + (F.lane & 31)];
            const float r = (F.lane < 32) ? (t1 * cs.x - t2 * cs.y) : (t1 * cs.y + t2 * cs.x);
            kr[(size_t)m * 64 + F.lane] = (bf16)f2bf(r); }
    }
}
__device__ __forceinline__ void q_rope(const Frame& F, bf16* q, const f32x2* ropetab) {
    for (int m = F.gw; m < SEQ; m += F.NGW) {
        bf16* qr = q + (size_t)m * NQ;
#pragma unroll
        for (int k = 0; k < 8; ++k) { const int pi = k * 64 + F.lane, h = pi >> 5, j = pi & 31;
            const f32x2 cs = ropetab[m * 32 + j];
            const float t1 = bflo(qr[h * 192 + 128 + j]), t2 = bflo(qr[h * 192 + 160 + j]);
            qr[h * 192 + 128 + j] = (bf16)f2bf(t1 * cs.x - t2 * cs.y); qr[h * 192 + 160 + j] = (bf16)f2bf(t1 * cs.y + t2 * cs.x); }
    }
}

__device__ __forceinline__ void attn_dilated_phase(LAS unsigned char* lds, const bf16* qkv, bf16* og, float* lse, int G, int bx) {
    for (int uix = bx; uix < 3 * 512; uix += G) {
        const int g = uix >> 9, rem = uix & 511, h = rem & 15, rb = rem >> 4, d = 1 << (2 * g), r = rb & (d - 1), b = rb >> (2 * g);
        const float slope = exp2f(-0.5f * (float)(h + 1)), scale = 0.08838834764831845f;
        fa::UnitArgs u;
        u.Q = qkv + (size_t)r * NQKV + h * HD; u.qs = (size_t)d * NQKV; u.K = u.Q + DM; u.ks = u.qs; u.Kr = nullptr; u.krs = 0; u.V = u.Q + 2 * DM; u.vs = u.qs;
        u.O = og + (size_t)g * SEQ * DM + (size_t)r * DM + h * HD; u.os = (size_t)d * DM; u.lse = lse + (size_t)g * SEQ * NHEAD + r * NHEAD + h; u.ls = (size_t)d * NHEAD;
        u.q0 = b * 256; u.W = 129; u.scale = scale; u.bias = slope * (float)d / scale;
        fa::attn_unit<128, true>(lds, u);
    }
}
__device__ __forceinline__ void attn_combine_phase(const Frame& F, const bf16* og, const float* lse, bf16* ao) {
    for (int p = F.gw; p < SEQ; p += F.NGW) {
#pragma unroll
        for (int j = 0; j < 4; ++j) { const int c0 = (j * 64 + F.lane) * 8, h = c0 >> 7;
            const float l0 = lse[(size_t)p * NHEAD + h], l1 = lse[(size_t)(SEQ + p) * NHEAD + h], l2 = lse[(size_t)(2 * SEQ + p) * NHEAD + h];
            const float mx = fmaxf(l0, fmaxf(l1, l2)); float w0 = __expf(l0 - mx), w1 = __expf(l1 - mx), w2 = __expf(l2 - mx);
            const float inv = 1.0f / (w0 + w1 + w2); w0 *= inv; w1 *= inv; w2 *= inv;
            const v4u a = *(const v4u*)(og + (size_t)p * DM + c0), b = *(const v4u*)(og + (size_t)(SEQ + p) * DM + c0), c = *(const v4u*)(og + (size_t)(2 * SEQ + p) * DM + c0);
            v4u o;
#pragma unroll
            for (int e = 0; e < 4; ++e) o[e] = pk2(w0 * bflo(a[e]) + w1 * bflo(b[e]) + w2 * bflo(c[e]), w0 * bfhi(a[e]) + w1 * bfhi(b[e]) + w2 * bfhi(c[e]));
            *(v4u*)(ao + (size_t)p * DM + c0) = o; }
    }
}
__device__ __forceinline__ void attn_mla_phase(LAS unsigned char* lds, const bf16* q, const bf16* kv, const bf16* kr, bf16* ao, int G, int bx) {
    for (int it = bx; it < 256; it += G) {
        const int xcd = it & 7, idx = it >> 3, h = xcd * 2 + (idx >> 4), pr = idx & 15;
        for (int pass = 0; pass < 2; ++pass) {
            fa::UnitArgs u;
            u.Q = q + h * 192; u.qs = NQ; u.K = kv + h * HD; u.ks = NUKV; u.Kr = kr; u.krs = 64; u.V = kv + DM + h * HD; u.vs = NUKV;
            u.O = ao + h * HD; u.os = DM; u.lse = nullptr; u.ls = 0; u.q0 = (pass ? 31 - pr : pr) * 256; u.W = 1 << 30; u.scale = 0.07216878364870322f; u.bias = 0.f;
            fa::attn_unit<192, false>(lds, u);
        }
    }
}

typedef const volatile Args __attribute__((address_space(4))) KArgs;
__global__ void __launch_bounds__(NWAVES * 64, 2) mk_fwd(Args args) {
    KArgs* const ka = (KArgs*)__builtin_amdgcn_kernarg_segment_ptr();
#define IN(k) ((const float*)ka->in[k])
    extern __shared__ __attribute__((aligned(16))) unsigned char lds_raw[];
    LAS unsigned char* const LDSB = (LAS unsigned char*)lds_raw;
    volatile LAS unsigned* MISC = (volatile LAS unsigned*)(LDSB + MISC_OFF);
    unsigned char* ws = args.ws;
    unsigned* const CTL = (unsigned*)(ws + WS_CTL);
    for (int u = threadIdx.x; u < (LDS_BYTES - LDSCTL_OFF) / 4; u += NWAVES * 64) ((LAS unsigned*)(LDSB + LDSCTL_OFF))[u] = 0u;
    __syncthreads();
    XcdBarrier bar; bar.bar = CTL + CW_BAR; bar.x = 0; bar.st = nullptr;
    if (!MK_PER_PHASE) bar = xcd_barrier_post(CTL + CW_BAR, MISC + 8);
    const int lo = args.ph_lo, hi = args.ph_hi;
    int ph = 0;
#define PH_BEGIN if (ph >= lo && ph < hi) { Frame F; F.lds = LDSB; F.ctl = CTL; F.tid = pg8::opaque_tid(); F.lane = F.tid & 63; F.wave = __builtin_amdgcn_readfirstlane(F.tid >> 6); F.G = gridDim.x; F.gw = blockIdx.x * NWAVES + F.wave; F.NGW = F.G * NWAVES;
#define PH_END } ++ph; if (!MK_PER_PHASE && ph > lo && ph < hi) xcd_barrier(bar);

    float* X = args.out;
    bf16* XB = (bf16*)(ws + WS_HB); float* SSQ = (float*)(ws + WS_SSQ); bf16* ACT = (bf16*)(ws + WS_ACT); bf16* QKV = (bf16*)(ws + WS_QKV); bf16* AO = (bf16*)(ws + WS_AO);
    bf16* KV = (bf16*)(ws + WS_KV); bf16* KR = (bf16*)(ws + WS_KR); bf16* CB = (bf16*)(ws + WS_CB);
    float* RAW = (float*)(ws + WS_ACT); bf16* OG = (bf16*)(ws + WS_OG); float* LSE = (float*)(ws + WS_LSE);
    const f32x2* ROPETAB = (const f32x2*)(ws + WS_ROPE);
    const int bx = blockIdx.x;

    PH_BEGIN p0_prologue(F, args); PH_END

    for (int s = 0; s < 8; ++s) {
        const int layer = s >> 1, which = s & 1;
        const float* xin = (s == 0) ? IN(0) : X;
        if (s == 4) {
            PH_BEGIN { pg8::Gemm g{XB, (const bf16*)(ws + WS_WKV), DM, DM, DM / 2}; pg8::StaticOrder S; S.init(SEQ, NKV1, 2, F.G, bx);
                       pg8::EpiF32 E{RAW, NKV1, (size_t)SEQ * NKV1};
                       pg8::gemm_phase<pg8::EpiF32, pg8::StaticOrder, true, true>(F.lds + RING_OFF, g, S, E); } PH_END
            PH_BEGIN latent_post<2, NKV1, true>(F, RAW, IN(14), CB, KR, ROPETAB, SSQ); PH_END
            PH_BEGIN { pg8::Gemm g{CB, (const bf16*)(ws + WS_WKV + 3 * MiB), KVR, KVR, KVR}; pg8::StaticOrder S; S.init(SEQ, NUKV, 1, F.G, bx);
                       pg8::EpiBf16 E{KV, NUKV, nullptr, 0};
                       pg8::gemm_phase<pg8::EpiBf16, pg8::StaticOrder, true, true>(F.lds + RING_OFF, g, S, E); } PH_END
        }
        PH_BEGIN { pg8::Gemm g{XB, (const bf16*)(ws + WS_W + (size_t)s * WFFN_B), DM, DM, DM}; pg8::StaticOrder S; S.init(SEQ, NUP, 1, F.G, bx);
                   pg8::Unit u0; const int fm256 = S.next(0, u0) ? (u0.pm & ~7) * 256 : 0; fill_rstd_tab(F, SSQ, fm256);
                   pg8::EpiSwiGLU E{ACT, FF, (const LAS float*)(F.lds + TAB_OFF), fm256};
                   pg8::gemm_phase<pg8::EpiSwiGLU, pg8::StaticOrder, true, true>(F.lds + RING_OFF, g, S, E); } PH_END
        PH_BEGIN { pg8::Gemm g{ACT, (const bf16*)(ws + WS_W + (size_t)s * WFFN_B + WGU_B), FF, FF, FF}; pg8::StaticOrder S; S.init(SEQ, DM, 1, F.G, bx);
                   pg8::EpiResidStats E{xin, X, XB, SSQ, DM, 0.5f};
                   pg8::gemm_phase<pg8::EpiResidStats, pg8::StaticOrder, false, true>(F.lds + RING_OFF, g, S, E); } PH_END
        if (which == 0) {
            if (layer < 2) {
                PH_BEGIN { pg8::Gemm g{XB, (const bf16*)(ws + WS_WA + (size_t)layer * WA_B), DM, DM, DM}; pg8::StaticOrder S; S.init(SEQ, NQKV, 1, F.G, bx);
                           pg8::Unit u0; const int fm256 = S.next(0, u0) ? (u0.pm & ~7) * 256 : 0; fill_rstd_tab(F, SSQ, fm256);
                           pg8::EpiBf16 E{QKV, NQKV, (const LAS float*)(F.lds + TAB_OFF), fm256};
                           pg8::gemm_phase<pg8::EpiBf16, pg8::StaticOrder, true, true>(F.lds + RING_OFF, g, S, E); } PH_END
                PH_BEGIN attn_dilated_phase(F.lds + RING_OFF, QKV, OG, LSE, F.G, bx); PH_END
                PH_BEGIN attn_combine_phase(F, OG, LSE, AO); PH_END
                PH_BEGIN { pg8::Gemm g{AO, (const bf16*)(ws + WS_WA + (size_t)layer * WA_B + 24 * MiB), DM, DM, DM}; pg8::StaticOrder S; S.init(SEQ, DM, 1, F.G, bx);
                           pg8::EpiResidStats E{X, X, XB, SSQ, DM, 1.0f};
                           pg8::gemm_phase<pg8::EpiResidStats, pg8::StaticOrder, false, true>(F.lds + RING_OFF, g, S, E); } PH_END
            } else {
                const int jb = layer - 2;
                PH_BEGIN { pg8::Gemm g{XB, (const bf16*)(ws + WS_WB + (size_t)jb * WB_B), DM, DM, DM / 4}; pg8::StaticOrder S; S.init(SEQ, QLR, 4, F.G, bx);
                           pg8::EpiF32 E{RAW, QLR, (size_t)SEQ * QLR};
                           pg8::gemm_phase<pg8::EpiF32, pg8::StaticOrder, true, true>(F.lds + RING_OFF, g, S, E); } PH_END
                PH_BEGIN latent_post<4, QLR, false>(F, RAW, IN(19) + (size_t)jb * QLR, CB, nullptr, ROPETAB, SSQ); PH_END
                PH_BEGIN { pg8::Gemm g{CB, (const bf16*)(ws + WS_WB + (size_t)jb * WB_B + 2 * MiB), QLR, QLR, QLR}; pg8::StaticOrder S; S.init(SEQ, NQ, 1, F.G, bx);
                           pg8::EpiBf16 E{QKV, NQ, nullptr, 0};
                           pg8::gemm_phase<pg8::EpiBf16, pg8::StaticOrder, true, true>(F.lds + RING_OFF, g, S, E); } PH_END
                PH_BEGIN q_rope(F, QKV, ROPETAB); PH_END
                PH_BEGIN attn_mla_phase(F.lds + RING_OFF, QKV, KV, KR, AO, F.G, bx); PH_END
                PH_BEGIN { pg8::Gemm g{AO, (const bf16*)(ws + WS_WB + (size_t)jb * WB_B + 8 * MiB), DM, DM, DM}; pg8::StaticOrder S; S.init(SEQ, DM, 1, F.G, bx);
                           pg8::EpiResidStats E{X, X, XB, SSQ, DM, 1.0f};
                           pg8::gemm_phase<pg8::EpiResidStats, pg8::StaticOrder, false, true>(F.lds + RING_OFF, g, S, E); } PH_END
            }
        }
    }
    PH_BEGIN norm_rows_f32(F, X, IN(22), X); PH_END
#undef PH_BEGIN
#undef PH_END
}
constexpr int N_PHASES = 1 + 8 * 2 + 2 * 4 + 2 * 6 + 3 + 1;

extern "C" void kernel_launch(void* const* d_in, const int* in_sizes, int n_in, void* d_out, int out_size, void* d_ws, size_t ws_size, hipStream_t stream) {
    static int grid = 0;
    if (grid == 0) {
        if (n_in != 23 || in_sizes[0] != SEQ * DM || out_size != SEQ * DM || ws_size < WS_END) {
            fprintf(stderr, "kernel_launch: shape/workspace mismatch: n_in %d in0 %d out %d ws %zu (need %zu); nothing launched\n", n_in, n_in > 0 ? in_sizes[0] : -1, out_size, ws_size, (size_t)WS_END); grid = -1; return; }
        int dev = 0, cus = 0, per_cu = 0;
        if (hipGetDevice(&dev) != hipSuccess || hipDeviceGetAttribute(&cus, hipDeviceAttributeMultiprocessorCount, dev) != hipSuccess) { fprintf(stderr, "kernel_launch: device query failed\n"); grid = -1; return; }
        if (hipFuncSetAttribute((const void*)mk_fwd, hipFuncAttributeMaxDynamicSharedMemorySize, LDS_BYTES) != hipSuccess) { fprintf(stderr, "kernel_launch: hipFuncSetAttribute failed\n"); grid = -1; return; }
        if (hipOccupancyMaxActiveBlocksPerMultiprocessor(&per_cu, (const void*)mk_fwd, NWAVES * 64, LDS_BYTES) != hipSuccess || per_cu < 1)
            fprintf(stderr, "kernel_launch: note: occupancy query reports %d workgroups per CU\n", per_cu);
        (void)hipGetLastError();
        grid = cus;
        if (grid != 256) { fprintf(stderr, "kernel_launch: built for a 256-CU device (one 256x256 unit per workgroup in the residual GEMM phases), found %d CUs; nothing launched\n", grid); grid = -1; return; }
    }
    if (grid < 0) return;
    if (hipMemsetAsync((char*)d_ws + WS_CTL, 0, CTL_ZERO_BYTES, stream) != hipSuccess) { fprintf(stderr, "kernel_launch: memset failed\n"); return; }
    Args a{};
    for (int i = 0; i < 23; ++i) a.in[i] = (const float*)d_in[i];
    a.out = (float*)d_out; a.ws = (unsigned char*)d_ws;
#if MK_PER_PHASE
    for (int p = 0; p < N_PHASES; ++p) { a.ph_lo = p; a.ph_hi = p + 1; hipLaunchKernelGGL(mk_fwd, dim3(grid), dim3(NWAVES * 64), LDS_BYTES, stream, a); }
#else
    a.ph_lo = 0; a.ph_hi = N_PHASES;
    hipLaunchKernelGGL(mk_fwd, dim3(grid), dim3(NWAVES * 64), LDS_BYTES, stream, a);
#endif
    const hipError_t le = hipPeekAtLastError();
    if (le != hipSuccess) fprintf(stderr, "kernel_launch: launch failed: %s\n", hipGetErrorName(le));
}
```

```cpp
#include <hip/hip_runtime.h>
#include <cstdio>
#include <cstdint>

#ifndef MK_PER_PHASE
#define MK_PER_PHASE 0
#endif

#ifndef SEAM_PROBE
#define SEAM_PROBE 0
#define SEAM_MASK 0xffffffffu
#endif
#ifndef PROBE_MASK
#define PROBE_MASK 0u
#endif

namespace pg8 {
#define PG8_LAS __attribute__((address_space(3)))
typedef unsigned short bf16_t;
typedef short bf16x8 __attribute__((ext_vector_type(8)));
typedef float f32x4 __attribute__((ext_vector_type(4)));
typedef float f32x2 __attribute__((ext_vector_type(2)));
typedef unsigned u32x4 __attribute__((ext_vector_type(4)));
constexpr int BM = 256, BK = 64, HALF = 128, HTB = HALF * BK * 2  , STAGE_BYTES = 8 * HTB, NXCD = 8, WGM = 4;

__host__ __device__ __forceinline__ int lds_byte(int r, int c) { const int st = (r >> 4) * 2 + (c >> 5), rr = r & 15, cc = c & 31, ob = rr * 64 + cc * 2; return st * 1024 + (ob ^ (((ob >> 9) & 1) << 5)); }
__host__ __device__ __forceinline__ void stage_rc(int b, int& R, int& C) { const int st = b / 1024, sb = b % 1024, swz = sb ^ (((sb >> 9) & 1) << 5); R = (st >> 1) * 16 + swz / 64; C = (st & 1) * 32 + (swz % 64) / 2; }
__host__ __device__ __forceinline__ int perm32(int rho) { const int n = rho >> 4, i = rho & 15; return 8 * (i >> 2) + 4 * n + (i & 3); }

struct Unit { int pm, pn, ks; };
struct Gemm { const bf16_t* A; const bf16_t* Bt; int lda, ldb, K; };

struct StaticOrder {
    int nM, nN, nS, nwg, G, c;
    __host__ __device__ void init(int M, int N, int nS_, int G_, int c_) { nM = M / BM; nN = N / BM; nS = nS_; nwg = nM * nN * nS; G = G_; c = c_; }
    __host__ __device__ __forceinline__ bool next(int i, Unit& u) const {
        const long L = (long)i * G + c; if (L >= nwg) return false;
        int wgid = (int)L; { const int q = nwg / NXCD, r = nwg % NXCD, xcd = wgid % NXCD, off = wgid / NXCD; wgid = (xcd < r ? xcd * (q + 1) : r * (q + 1) + (xcd - r) * q) + off; }
        const int nNN = nN * nS, nig = WGM * nNN, gid = wgid / nig, fm = gid * WGM, gsz = (nM - fm) < WGM ? (nM - fm) : WGM;
        u.pm = fm + ((wgid % nig) % gsz); const int pq = (wgid % nig) / gsz; u.pn = pq % nN; u.ks = pq / nN; return true;
    }
    __device__ __forceinline__ void a_ready(const Unit&) const {}
    __device__ __forceinline__ void done(const Unit&) const {}
};

__device__ __forceinline__ unsigned cvt_pk_bf16(float lo, float hi) { unsigned r; asm volatile("v_cvt_pk_bf16_f32 %0, %1, %2" : "=v"(r) : "v"(lo), "v"(hi)); return r; }

__device__ __forceinline__ int opaque_tid() { int t; asm volatile("v_mov_b32 %0, %1" : "=v"(t) : "v"(threadIdx.x)); return t; }
struct EpiBf16 {
    static constexpr bool PERM = true, AFTER_DRAIN = false;
    bf16_t* O; int ldc; const PG8_LAS float* tab; int fm256; size_t slice = 0;
    __device__ __forceinline__ void operator()(const f32x4 (&acc)[2][2][4][2], const Unit& u, int wr, int wc, int fr, int fq) const {
        const int row0 = u.pm * BM + wr * 64 + fr, col0 = u.pn * BM + wc * 32 + 8 * fq;
#pragma unroll
        for (int ai = 0; ai < 2; ++ai)
#pragma unroll
            for (int m = 0; m < 4; ++m) { const int row = row0 + ai * HALF + m * 16; bf16_t* rowp = O + (size_t)u.ks * slice + (size_t)row * ldc + col0;
                const float rs = tab ? tab[row - fm256] : 1.0f;
#pragma unroll
                for (int bj = 0; bj < 2; ++bj) { const f32x4 v0 = acc[ai][bj][m][0] * rs, v1 = acc[ai][bj][m][1] * rs;
                    u32x4 w; w.x = cvt_pk_bf16(v0[0], v0[1]); w.y = cvt_pk_bf16(v0[2], v0[3]); w.z = cvt_pk_bf16(v1[0], v1[1]); w.w = cvt_pk_bf16(v1[2], v1[3]);
                    *(u32x4*)(rowp + bj * HALF) = w; } }
    }
};
struct EpiSwiGLU {
    static constexpr bool PERM = true, AFTER_DRAIN = false;
    bf16_t* O; int ldc; const PG8_LAS float* tab; int fm256;
    __device__ __forceinline__ void operator()(const f32x4 (&acc)[2][2][4][2], const Unit& u, int wr, int wc, int fr, int fq) const {
        const int row0 = u.pm * BM + wr * 64 + fr, col0 = u.pn * HALF + wc * 32 + 8 * fq;
#pragma unroll
        for (int ai = 0; ai < 2; ++ai)
#pragma unroll
            for (int m = 0; m < 4; ++m) { const int row = row0 + ai * HALF + m * 16; bf16_t* rowp = O + (size_t)row * ldc + col0;
                const float rs = tab[row - fm256];
                float r[8];
#pragma unroll
                for (int n = 0; n < 2; ++n)
#pragma unroll
                    for (int e = 0; e < 4; ++e) { const float gv = acc[ai][0][m][n][e] * rs, uv = acc[ai][1][m][n][e] * rs;
                        const float sg = gv * __builtin_amdgcn_rcpf(1.0f + __builtin_amdgcn_exp2f(-1.4426950408889634f * gv));
                        r[n * 4 + e] = sg * uv; }
                u32x4 w; w.x = cvt_pk_bf16(r[0], r[1]); w.y = cvt_pk_bf16(r[2], r[3]); w.z = cvt_pk_bf16(r[4], r[5]); w.w = cvt_pk_bf16(r[6], r[7]);
                *(u32x4*)rowp = w; }
    }
};
__device__ __forceinline__ float bf_lo(unsigned u) { return __builtin_bit_cast(float, u << 16); }
__device__ __forceinline__ float bf_hi(unsigned u) { return __builtin_bit_cast(float, u & 0xffff0000u); }
#ifndef RESID_LO
#define RESID_LO 0
#endif
#if RESID_LO
#define RS_LOAD(ai, m0) do { _Pragma("unroll") for (int m = 0; m < 2; ++m) _Pragma("unroll") for (int bj = 0; bj < 2; ++bj) { \
            const size_t off = (size_t)(row0 + (ai) * HALF + ((m0) + m) * 16) * ldc + col0 + bj * HALF; bh[m][bj] = *(const u32x4*)(hi + off); bl[m][bj] = *(const u32x4*)(lo + off); } } while (0)
#define RS_ADD(ai, m0) do { _Pragma("unroll") for (int m = 0; m < 2; ++m) _Pragma("unroll") for (int bj = 0; bj < 2; ++bj) _Pragma("unroll") for (int n = 0; n < 2; ++n) { \
            const unsigned h0 = bh[m][bj][2 * n], h1 = bh[m][bj][2 * n + 1], l0 = bl[m][bj][2 * n], l1 = bl[m][bj][2 * n + 1]; \
            const f32x4 xo = {bf_lo(h0) + bf_lo(l0), bf_hi(h0) + bf_hi(l0), bf_lo(h1) + bf_lo(l1), bf_hi(h1) + bf_hi(l1)}; \
            acc[ai][bj][(m0) + m][n] = xo + acc[ai][bj][(m0) + m][n] * scale; } } while (0)
#else
#define RS_LOADH(B, ai, m0) do { _Pragma("unroll") for (int m = 0; m < 2; ++m) _Pragma("unroll") for (int bj = 0; bj < 2; ++bj) { \
            const size_t off = (size_t)(row0 + (ai) * HALF + ((m0) + m) * 16) * ldc + col0 + bj * HALF; B[m][bj] = *(const u32x4*)(hi + off); } } while (0)
#define RS_ADDH(B, ai, m0) do { _Pragma("unroll") for (int m = 0; m < 2; ++m) _Pragma("unroll") for (int bj = 0; bj < 2; ++bj) _Pragma("unroll") for (int n = 0; n < 2; ++n) { \
            const unsigned h0 = B[m][bj][2 * n], h1 = B[m][bj][2 * n + 1]; \
            const f32x4 xo = {bf_lo(h0), bf_hi(h0), bf_lo(h1), bf_hi(h1)}; \
            acc[ai][bj][(m0) + m][n] = xo + acc[ai][bj][(m0) + m][n] * scale; } } while (0)
#define RS_LOAD(ai, m0) do { if ((m0) == 0) { RS_LOADH(bh, ai, 0); RS_LOADH(bl, ai, 2); } } while (0)
#define RS_ADD(ai, m0) do { if ((m0) == 0) { RS_ADDH(bh, ai, 0); RS_ADDH(bl, ai, 2); } } while (0)
#endif
#define RS_SUMSQ(ai, m, s) do { _Pragma("unroll") for (int bj = 0; bj < 2; ++bj) _Pragma("unroll") for (int n = 0; n < 2; ++n) { const f32x4 v = acc[ai][bj][m][n]; \
            s += (v[0] * v[0] + v[1] * v[1]) + (v[2] * v[2] + v[3] * v[3]); } \
            s += __shfl_xor(s, 16); s += __shfl_xor(s, 32); \
            if (fq == 0) P[((ai) * HALF + wr * 64 + (m) * 16 + fr) * 4 + wc] = s; } while (0)
#define RS_FENCE asm volatile("" ::: "memory")
struct EpiResidStats {
    static constexpr bool PERM = true, AFTER_DRAIN = true;
    bf16_t* hi; bf16_t* lo; float* ssq; int ldc; float scale;
    __device__ __forceinline__ void fused(f32x4 (&acc)[2][2][4][2], const Unit& u, int wr, int wc, int fr, int fq, PG8_LAS unsigned char* lds, int wid, int lane) const {
        PG8_LAS float* P = (PG8_LAS float*)lds;
        const int row0 = u.pm * BM + wr * 64 + fr, col0 = u.pn * BM + wc * 32 + 8 * fq;
        u32x4 bh[2][2], bl[2][2];
#if RESID_LO
#define RS_STORE_LO(h, v0, v1, off) do { u32x4 l; l.x = cvt_pk_bf16(v0[0] - bf_lo(h.x), v0[1] - bf_hi(h.x)); l.y = cvt_pk_bf16(v0[2] - bf_lo(h.y), v0[3] - bf_hi(h.y)); \
                l.z = cvt_pk_bf16(v1[0] - bf_lo(h.z), v1[1] - bf_hi(h.z)); l.w = cvt_pk_bf16(v1[2] - bf_lo(h.w), v1[3] - bf_hi(h.w)); *(u32x4*)(lo + off) = l; } while (0)
#else
#define RS_STORE_LO(h, v0, v1, off) do { } while (0)
#endif
#define RS_STORE(ai, m0) do { _Pragma("unroll") for (int m = (m0); m < (m0) + 2; ++m) { float s = 0.f; \
            _Pragma("unroll") for (int bj = 0; bj < 2; ++bj) { const size_t off = (size_t)(row0 + (ai) * HALF + m * 16) * ldc + col0 + bj * HALF; const f32x4 v0 = acc[ai][bj][m][0], v1 = acc[ai][bj][m][1]; \
                u32x4 h; h.x = cvt_pk_bf16(v0[0], v0[1]); h.y = cvt_pk_bf16(v0[2], v0[3]); h.z = cvt_pk_bf16(v1[0], v1[1]); h.w = cvt_pk_bf16(v1[2], v1[3]); \
                RS_STORE_LO(h, v0, v1, off); *(u32x4*)(hi + off) = h; } \
            RS_SUMSQ(ai, m, s); } } while (0)
#if RESID_LO
        RS_LOAD(0, 0); RS_ADD(0, 0); RS_FENCE;
        RS_LOAD(0, 2); RS_FENCE; RS_STORE(0, 0); RS_ADD(0, 2); RS_FENCE;
        RS_LOAD(1, 0); RS_FENCE; RS_STORE(0, 2); RS_ADD(1, 0); RS_FENCE;
        RS_LOAD(1, 2); RS_FENCE; RS_STORE(1, 0); RS_ADD(1, 2); RS_FENCE;
        RS_STORE(1, 2);
#else
        RS_LOAD(0, 0); RS_ADD(0, 0); RS_FENCE;
        RS_LOAD(1, 0); RS_FENCE; RS_STORE(0, 0); RS_STORE(0, 2); RS_ADD(1, 0); RS_FENCE;
        RS_STORE(1, 0); RS_STORE(1, 2);
#endif
#undef RS_STORE
#undef RS_STORE_LO
        asm volatile("s_waitcnt lgkmcnt(0)" ::: "memory"); __builtin_amdgcn_s_barrier(); asm volatile("" ::: "memory");
        const int t = wid * 64 + lane;
        if (t < 256) { const f32x4 p = *(const PG8_LAS f32x4*)(P + t * 4); ssq[(size_t)(u.pm * BM + t) * 8 + u.pn] = (p[0] + p[1]) + (p[2] + p[3]); }
        asm volatile("s_waitcnt lgkmcnt(0)" ::: "memory"); __builtin_amdgcn_s_barrier(); asm volatile("" ::: "memory");
    }
};
struct EpiResidFinal {
    static constexpr bool PERM = true, AFTER_DRAIN = true;
    const bf16_t* hi; const bf16_t* lo; float* out; float* ssq; const float* gain; unsigned* cnt; unsigned* tmo; int ldc; float scale, eps;
    __device__ __forceinline__ void fused(f32x4 (&acc)[2][2][4][2], const Unit& u, int wr, int wc, int fr, int fq, PG8_LAS unsigned char* lds, int wid, int lane) const {
        PG8_LAS float* P = (PG8_LAS float*)lds;
        const int row0 = u.pm * BM + wr * 64 + fr, col0 = u.pn * BM + wc * 32 + 8 * fq;
        u32x4 bh[2][2], bl[2][2];
#define RS_SSQ(ai, m0) do { _Pragma("unroll") for (int m = (m0); m < (m0) + 2; ++m) { float s = 0.f; RS_SUMSQ(ai, m, s); } } while (0)
#if RESID_LO
        RS_LOAD(0, 0); RS_ADD(0, 0); RS_FENCE;
        RS_LOAD(0, 2); RS_FENCE; RS_SSQ(0, 0); RS_ADD(0, 2); RS_FENCE;
        RS_LOAD(1, 0); RS_FENCE; RS_SSQ(0, 2); RS_ADD(1, 0); RS_FENCE;
        RS_LOAD(1, 2); RS_FENCE; RS_SSQ(1, 0); RS_ADD(1, 2); RS_FENCE;
        RS_SSQ(1, 2);
#else
        RS_LOAD(0, 0); RS_ADD(0, 0); RS_FENCE;
        RS_LOAD(1, 0); RS_FENCE; RS_SSQ(0, 0); RS_SSQ(0, 2); RS_ADD(1, 0); RS_FENCE;
        RS_SSQ(1, 0); RS_SSQ(1, 2);
#endif
#undef RS_SSQ
        asm volatile("s_waitcnt lgkmcnt(0)" ::: "memory"); __builtin_amdgcn_s_barrier(); asm volatile("" ::: "memory");
        const int t = wid * 64 + lane;
        if (t < 256) { const f32x4 p = *(const PG8_LAS f32x4*)(P + t * 4); ssq[(size_t)(u.pm * BM + t) * 8 + u.pn] = (p[0] + p[1]) + (p[2] + p[3]); }
        asm volatile("s_waitcnt vmcnt(0) lgkmcnt(0)" ::: "memory"); __syncthreads();
        if (t == 0) {
            __builtin_amdgcn_fence(__ATOMIC_RELEASE, "agent"); asm volatile("s_waitcnt vmcnt(0)" ::: "memory");
            (void)__hip_atomic_fetch_add(cnt + 16 * u.pm, 1u, __ATOMIC_RELAXED, __HIP_MEMORY_SCOPE_AGENT);
            unsigned sp = 0u;
            while (__hip_atomic_load(cnt + 16 * u.pm, __ATOMIC_RELAXED, __HIP_MEMORY_SCOPE_AGENT) < 8u) { __builtin_amdgcn_s_sleep(1);
                if ((++sp & 255u) == 0u) { if (__hip_atomic_load(tmo, __ATOMIC_RELAXED, __HIP_MEMORY_SCOPE_AGENT)) break; if (sp > (1u << 18)) { atomicAdd(tmo, 1u); break; } } }
            __builtin_amdgcn_fence(__ATOMIC_ACQUIRE, "agent"); asm volatile("s_waitcnt vmcnt(0)" ::: "memory");
        }
        __syncthreads();
        f32x4 g[2][2];
#pragma unroll
        for (int bj = 0; bj < 2; ++bj)
#pragma unroll
            for (int n = 0; n < 2; ++n) g[bj][n] = *(const f32x4*)(gain + col0 + bj * HALF + n * 4);
#pragma unroll
        for (int ai = 0; ai < 2; ++ai)
#pragma unroll
            for (int m = 0; m < 4; ++m) { const int row = row0 + ai * HALF + m * 16;
                const f32x4 s0 = *(const f32x4*)(ssq + (size_t)row * 8), s1 = *(const f32x4*)(ssq + (size_t)row * 8 + 4);
                const float s = ((s0[0] + s0[1]) + (s0[2] + s0[3])) + ((s1[0] + s1[1]) + (s1[2] + s1[3]));
                const float rstd = 1.0f / sqrtf(s * (1.0f / 2048.0f) + eps);
                const size_t off = (size_t)row * ldc + col0;
#pragma unroll
                for (int bj = 0; bj < 2; ++bj)
#pragma unroll
                    for (int n = 0; n < 2; ++n) __builtin_nontemporal_store(acc[ai][bj][m][n] * rstd * g[bj][n], (f32x4*)(out + off + bj * HALF + n * 4)); }
    }
};
#undef RS_FENCE
#undef RS_LOAD
#undef RS_ADD
#undef RS_SUMSQ
#if !RESID_LO
#undef RS_LOADH
#undef RS_ADDH
#endif
struct EpiF32 {
    static constexpr bool PERM = false, AFTER_DRAIN = false;
    float* O; int ldc; size_t slice;
    __device__ __forceinline__ void operator()(const f32x4 (&acc)[2][2][4][2], const Unit& u, int wr, int wc, int fr, int fq) const {
        const int row0 = u.pm * BM + wr * 64 + fr, col0 = u.pn * BM + wc * 32 + 4 * fq; float* Ob = O + (size_t)u.ks * slice;
#pragma unroll
        for (int ai = 0; ai < 2; ++ai)
#pragma unroll
            for (int m = 0; m < 4; ++m) { const size_t off = (size_t)(row0 + ai * HALF + m * 16) * ldc + col0;
#pragma unroll
                for (int bj = 0; bj < 2; ++bj)
#pragma unroll
                    for (int n = 0; n < 2; ++n) *(f32x4*)(Ob + off + bj * HALF + n * 16) = acc[ai][bj][m][n];
            }
    }
};

template <class Epi, class Sched, bool ALIGN_EPI = false, bool SP2 = false>
__device__ __forceinline__ void gemm_phase(PG8_LAS unsigned char* lds, const Gemm g, const Sched& S, const Epi& E) {
    const int tid = opaque_tid(), wid = __builtin_amdgcn_readfirstlane(tid >> 6), lane = tid & 63, wr = wid >> 2, wc = wid & 3, fr = lane & 15, fq = lane >> 4;
    const int K = g.K, nt = K / BK;
#define PG8_UA(u) ((const char*)g.A + ((size_t)(u).pm * BM * g.lda + (size_t)(u).ks * K) * 2)
#define PG8_UB(u) ((const char*)g.Bt + ((size_t)(u).pn * BM * g.ldb + (size_t)(u).ks * K) * 2)
    unsigned voffA[2], voffB[2];
#pragma unroll
    for (int i = 0; i < 2; ++i) { int R, C; stage_rc(tid * 16 + i * 8192, R, C); const int Rb = Epi::PERM ? ((R & ~31) + perm32(R & 31)) : R;
        voffA[i] = (unsigned)(R * g.lda + C) * 2u; voffB[i] = (unsigned)(Rb * g.ldb + C) * 2u; }
    const size_t kstep = (size_t)(BK * 2);
    const size_t hstepA = (size_t)HALF * g.lda * 2, hstepB = (size_t)HALF * g.ldb * 2;
    const unsigned ldsw = (unsigned)wid * 1024u;
    const int aoff = lds_byte(wr * 64 + fr, fq * 8), boff = lds_byte(wc * 32 + fr, fq * 8);
#define PG8_SA(b, h) (((b) * 2 + (h)) * HTB)
#define PG8_SB(b, h) ((4 + (b) * 2 + (h)) * HTB)
#define PG8_STAGE(bufoff, gbase, voff) do { _Pragma("unroll") for (int _i = 0; _i < 2; ++_i) \
        __builtin_amdgcn_global_load_lds((const unsigned*)((const char*)(gbase) + (voff)[_i]), (PG8_LAS unsigned*)(lds + (bufoff) + ldsw + _i * 8192), 16, 0, 0); } while (0)
#define PG8_LDA(dst, b, h) do { _Pragma("unroll") for (int m = 0; m < 4; ++m) _Pragma("unroll") for (int k = 0; k < 2; ++k) dst[m][k] = *(const PG8_LAS bf16x8*)(lds + PG8_SA(b, h) + aoff + m * 2048 + k * 1024); } while (0)
#define PG8_LDB(dst, b, h) do { _Pragma("unroll") for (int n = 0; n < 2; ++n) _Pragma("unroll") for (int k = 0; k < 2; ++k) dst[n][k] = *(const PG8_LAS bf16x8*)(lds + PG8_SB(b, h) + boff + n * 2048 + k * 1024); } while (0)
#define PG8_MMA(ai, bj, At, Bt) do { __builtin_amdgcn_s_setprio(1); _Pragma("unroll") for (int m = 0; m < 4; ++m) _Pragma("unroll") for (int n = 0; n < 2; ++n) _Pragma("unroll") for (int k = 0; k < 2; ++k) \
        acc[ai][bj][m][n] = __builtin_amdgcn_mfma_f32_16x16x32_bf16(Bt[n][k], At[m][k], acc[ai][bj][m][n], 0, 0, 0); __builtin_amdgcn_s_setprio(0); } while (0)
#define PG8_WAIT_V(n) asm volatile("s_waitcnt vmcnt(" #n ")" ::: "memory")
#define PG8_WAIT_L(n) asm volatile("s_waitcnt lgkmcnt(" #n ")" ::: "memory")
#define PG8_BAR __builtin_amdgcn_s_barrier()
#define PG8_SCHED __builtin_amdgcn_sched_barrier(0)
    Unit cur, nxt; int ui = 0;
    if (!S.next(0, cur)) return;
    f32x4 acc[2][2][4][2];
#pragma unroll
    for (int a = 0; a < 2; ++a)
#pragma unroll
        for (int b = 0; b < 2; ++b)
#pragma unroll
            for (int m = 0; m < 4; ++m)
#pragma unroll
                for (int n = 0; n < 2; ++n) acc[a][b][m][n] = (f32x4){0.f, 0.f, 0.f, 0.f};
    bf16x8 At[4][2], B0[2][2], B1[2][2];
    const char* cA = PG8_UA(cur); const char* cB = PG8_UB(cur);
    S.a_ready(cur);
    if constexpr (SP2) {
        PG8_STAGE(PG8_SB(0, 0), cB, voffB); PG8_STAGE(PG8_SB(0, 1), cB + hstepB, voffB); PG8_STAGE(PG8_SA(0, 0), cA, voffA); PG8_STAGE(PG8_SA(0, 1), cA + hstepA, voffA);
        if (wr == 1) PG8_BAR;
        PG8_WAIT_V(2); PG8_BAR;
        PG8_STAGE(PG8_SB(1, 0), cB + kstep, voffB); PG8_STAGE(PG8_SA(1, 0), cA + kstep, voffA); PG8_STAGE(PG8_SB(1, 1), cB + hstepB + kstep, voffB);
        PG8_WAIT_V(6); PG8_BAR;
    } else {
        PG8_STAGE(PG8_SB(0, 0), cB, voffB); PG8_STAGE(PG8_SA(0, 0), cA, voffA); PG8_STAGE(PG8_SB(0, 1), cB + hstepB, voffB); PG8_STAGE(PG8_SA(0, 1), cA + hstepA, voffA);
        if (wr == 1) PG8_BAR;
        PG8_WAIT_V(4); PG8_BAR;
        PG8_STAGE(PG8_SB(1, 0), cB + kstep, voffB); PG8_STAGE(PG8_SA(1, 0), cA + kstep, voffA); PG8_STAGE(PG8_SB(1, 1), cB + hstepB + kstep, voffB);
        PG8_WAIT_V(6); PG8_BAR;
    }
    for (;;) {
        const bool has_next = S.next(ui + 1, nxt);
        const char* nA = has_next ? PG8_UA(nxt) : cA; const char* nB = has_next ? PG8_UB(nxt) : cB;
        for (int t = 0; t < nt; t += 2) {
            const bool last = (t == nt - 2);
            const char* a1 = cA + (size_t)(t + 1) * kstep;
            const char* a2 = last ? nA : cA + (size_t)(t + 2) * kstep; const char* b2 = last ? nB : cB + (size_t)(t + 2) * kstep;
            const char* a3 = a2 + kstep; const char* b3 = b2 + kstep;
            if (last && has_next) S.a_ready(nxt);
            if constexpr (SP2) {
            PG8_LDB(B0, 0, 0); PG8_LDB(B1, 0, 1); PG8_SCHED; PG8_LDA(At, 0, 0); PG8_STAGE(PG8_SA(1, 1), a1 + hstepA, voffA);
            PG8_WAIT_V(8); PG8_WAIT_L(0); PG8_BAR; PG8_MMA(0, 0, At, B0); PG8_MMA(0, 1, At, B1); PG8_BAR; PG8_SCHED;
            PG8_LDA(At, 0, 1); PG8_STAGE(PG8_SB(0, 0), b2, voffB); PG8_STAGE(PG8_SB(0, 1), b2 + hstepB, voffB); PG8_STAGE(PG8_SA(0, 0), a2, voffA);
            PG8_WAIT_V(8); PG8_WAIT_L(0); PG8_BAR; PG8_MMA(1, 0, At, B0); PG8_MMA(1, 1, At, B1); PG8_BAR; PG8_SCHED;
            PG8_LDB(B0, 1, 0); PG8_LDB(B1, 1, 1); PG8_SCHED; PG8_LDA(At, 1, 0); PG8_STAGE(PG8_SA(0, 1), a2 + hstepA, voffA);
            PG8_WAIT_V(8); PG8_WAIT_L(0); PG8_BAR; PG8_MMA(0, 0, At, B0); PG8_MMA(0, 1, At, B1); PG8_BAR; PG8_SCHED;
            PG8_LDA(At, 1, 1); PG8_STAGE(PG8_SB(1, 0), b3, voffB); PG8_STAGE(PG8_SB(1, 1), b3 + hstepB, voffB); PG8_STAGE(PG8_SA(1, 0), a3, voffA);
            PG8_WAIT_V(8); PG8_WAIT_L(0); PG8_BAR; PG8_MMA(1, 0, At, B0); PG8_MMA(1, 1, At, B1); PG8_BAR; PG8_SCHED;
            } else {
            PG8_LDB(B0, 0, 0); PG8_SCHED; PG8_LDA(At, 0, 0); PG8_STAGE(PG8_SA(1, 1), a1 + hstepA, voffA);
            PG8_WAIT_L(8); PG8_BAR; PG8_WAIT_L(0); PG8_MMA(0, 0, At, B0); PG8_BAR; PG8_SCHED;
            PG8_LDB(B1, 0, 1); PG8_STAGE(PG8_SB(0, 0), b2, voffB);
            PG8_BAR; PG8_WAIT_L(0); PG8_MMA(0, 1, At, B1); PG8_BAR;
            PG8_LDA(At, 0, 1); PG8_STAGE(PG8_SA(0, 0), a2, voffA);
            PG8_BAR; PG8_WAIT_L(0); PG8_MMA(1, 0, At, B0); PG8_BAR; PG8_SCHED;
            PG8_STAGE(PG8_SB(0, 1), b2 + hstepB, voffB);
            PG8_WAIT_V(6); PG8_BAR; PG8_MMA(1, 1, At, B1); PG8_BAR;
            PG8_LDB(B0, 1, 0); PG8_SCHED; PG8_LDA(At, 1, 0); PG8_STAGE(PG8_SA(0, 1), a2 + hstepA, voffA);
            PG8_WAIT_L(8); PG8_BAR; PG8_WAIT_L(0); PG8_MMA(0, 0, At, B0); PG8_BAR; PG8_SCHED;
            PG8_LDB(B1, 1, 1); PG8_STAGE(PG8_SB(1, 0), b3, voffB);
            PG8_BAR; PG8_WAIT_L(0); PG8_MMA(0, 1, At, B1); PG8_BAR;
            PG8_LDA(At, 1, 1); PG8_STAGE(PG8_SA(1, 0), a3, voffA);
            PG8_BAR; PG8_WAIT_L(0); PG8_MMA(1, 0, At, B0); PG8_BAR; PG8_SCHED;
            PG8_STAGE(PG8_SB(1, 1), b3 + hstepB, voffB);
            PG8_WAIT_V(6); PG8_BAR; PG8_MMA(1, 1, At, B1); PG8_BAR;
            }
        }
        if constexpr (ALIGN_EPI) { if (wr == 0) PG8_BAR; }
        if constexpr (!Epi::AFTER_DRAIN) { E(acc, cur, wr, wc, fr, fq); S.done(cur); }
        if (!has_next) break;
#pragma unroll
        for (int a = 0; a < 2; ++a)
#pragma unroll
            for (int b = 0; b < 2; ++b)
#pragma unroll
                for (int m = 0; m < 4; ++m)
#pragma unroll
                    for (int n = 0; n < 2; ++n) acc[a][b][m][n] = (f32x4){0.f, 0.f, 0.f, 0.f};
        cur = nxt; cA = nA; cB = nB; ++ui;
        if constexpr (ALIGN_EPI) { if (wr == 1) PG8_BAR; }
    }
    PG8_WAIT_V(0);
    if constexpr (!ALIGN_EPI) { if (wr == 0) PG8_BAR; }
    PG8_BAR;
    if constexpr (Epi::AFTER_DRAIN) { E.fused(acc, cur, wr, wc, fr, fq, lds, wid, lane); S.done(cur); }
#undef PG8_UA
#undef PG8_UB
#undef PG8_SA
#undef PG8_SB
#undef PG8_STAGE
#undef PG8_LDA
#undef PG8_LDB
#undef PG8_MMA
#undef PG8_WAIT_V
#undef PG8_WAIT_L
#undef PG8_BAR
#undef PG8_SCHED
}
}

#define LAS __attribute__((address_space(3)))
#define GAS __attribute__((address_space(1)))
#define XB_TMO      128
#define XB_XCNT(j)  (256  + 64 * (j))
#define XB_XSUB(j)  (1280 + 64 * (j))
#define XB_XGEN(j)  (2304 + 64 * (j))
#define XB_TOP      3328
#define XB_TOPGEN   3392
#define XCD_BAR_WORDS 3456
#define XB_LSUB(j)  (6144 + 64 * (j))
#define XB_LGEN(j)  (7168 + 64 * (j))
#define XB_SPIN_CAP (1u << 18)
#ifndef EARLY_INV
#define EARLY_INV 1
#endif
#ifndef TOP_POLL
#define TOP_POLL 1
#endif

__device__ __forceinline__ unsigned xb_ld(unsigned* p)              { return __hip_atomic_load(p, __ATOMIC_RELAXED, __HIP_MEMORY_SCOPE_AGENT); }
__device__ __forceinline__ unsigned xb_add(unsigned* p, unsigned v) { return __hip_atomic_fetch_add(p, v, __ATOMIC_RELAXED, __HIP_MEMORY_SCOPE_AGENT); }
__device__ __forceinline__ unsigned xb_xcc_id() { return (unsigned)__builtin_amdgcn_s_getreg((3 << 11) | 20) & 0xFu; }
#define XB_SPIN(cond, bar) do { unsigned _sp = 0; while (cond) { __builtin_amdgcn_s_sleep(1); \
    if ((++_sp & 255u) == 0u) { if (xb_ld(&(bar)[XB_TMO])) break; if (_sp > XB_SPIN_CAP) { atomicAdd(&(bar)[XB_TMO], 1u); break; } } } } while (0)

struct XcdBarrier {
    unsigned* bar; unsigned x;
    volatile LAS unsigned* st;
#if SEAM_PROBE
    unsigned probe;
#endif
};

__device__ __forceinline__ XcdBarrier xcd_barrier_post(unsigned* bar, volatile LAS unsigned* st) {
    XcdBarrier b; b.bar = bar; b.x = xb_xcc_id(); b.st = st;
    if (threadIdx.x == 0) st[2] = xb_add(&bar[XB_XCNT(b.x)], 1u);
    return b;
}
__device__ __forceinline__ void xcd_barrier_complete(unsigned* bar, unsigned x, unsigned& nloc, unsigned& nx) {
    const unsigned G = gridDim.x * gridDim.y * gridDim.z;
    unsigned sum, cnt, mine, sp = 0u;
    for (;;) {
        sum = 0u; cnt = 0u; mine = 0u;
#pragma unroll
        for (unsigned j = 0; j < 16; ++j) { const unsigned c = xb_ld(&bar[XB_XCNT(j)]); sum += c; cnt += (c > 0u) ? 1u : 0u; mine = (j == x) ? c : mine; }
        if (sum == G) break;
        __builtin_amdgcn_s_sleep(1);
        if ((++sp & 255u) == 0u) { if (xb_ld(&bar[XB_TMO])) break; if (sp > XB_SPIN_CAP) { atomicAdd(&bar[XB_TMO], 1u); break; } }
    }
    nloc = mine > 0u ? mine : 1u; nx = cnt > 0u ? cnt : 1u;
}

__device__ __forceinline__ void xcd_barrier(const XcdBarrier& b) {
    asm volatile("s_waitcnt vmcnt(0)" ::: "memory");
    __syncthreads();
    if (threadIdx.x == 0) {
        unsigned* bar = b.bar;
#if SEAM_PROBE
        const unsigned seam_t0 = (unsigned)__builtin_amdgcn_s_memrealtime();
#endif
        __builtin_amdgcn_s_waitcnt(0);
        unsigned nloc = b.st[0], nx = b.st[1];
        if (nloc == 0u) { xcd_barrier_complete(bar, b.x, nloc, nx); b.st[0] = nloc; b.st[1] = nx;
            unsigned ok = (nx == 8u && gridDim.x == 256u) ? 1u : 0u;
#pragma unroll
            for (unsigned j = 0; j < 16; ++j) { const unsigned c = xb_ld(&bar[XB_XCNT(j)]); if (c != 0u && c != 32u) ok = 0u; }
            if (b.x >= 8u || b.st[2] >= 32u) ok = 0u;
            b.st[3] = ok; b.st[4] = ok ? (b.st[2] * 8u + b.x) : blockIdx.x; }
        const unsigned old = xb_add(&bar[XB_XSUB(b.x)], 1u);
        const unsigned gen = old / nloc;
        if (old + 1u == (gen + 1u) * nloc) {
#if SEAM_PROBE == 2
            const unsigned fence_t0 = (unsigned)__builtin_amdgcn_s_memrealtime();
#endif
            __builtin_amdgcn_fence(__ATOMIC_RELEASE, "agent");
            asm volatile("s_waitcnt vmcnt(0)" ::: "memory");
#if SEAM_PROBE == 2
            if (b.probe) atomicAdd(&bar[8192 - 4096], ((unsigned)__builtin_amdgcn_s_memrealtime() - fence_t0) * 32u);
#endif
#if SEAM_PROBE == 3
            const unsigned top_t0 = (unsigned)__builtin_amdgcn_s_memrealtime();
#endif
#if TOP_POLL
            (void)xb_add(&bar[XB_TOP], 1u);
            const unsigned target = (gen + 1u) * nx;
            XB_SPIN(xb_ld(&bar[XB_TOP]) < target, bar);
#else
            const unsigned og = xb_add(&bar[XB_TOP], 1u);
            const unsigned tg = og / nx;
            if (og + 1u == (tg + 1u) * nx) xb_add(&bar[XB_TOPGEN], 1u);
            else XB_SPIN(xb_ld(&bar[XB_TOPGEN]) == tg, bar);
#endif
#if SEAM_PROBE == 3
            if (b.probe) atomicAdd(&bar[8192 - 4096], ((unsigned)__builtin_amdgcn_s_memrealtime() - top_t0) * 32u);
#endif
            __builtin_amdgcn_fence(__ATOMIC_ACQUIRE, "agent");
            xb_add(&bar[XB_XGEN(b.x)], 1u);
            asm volatile("s_waitcnt vmcnt(0)" ::: "memory");
        } else {
#if EARLY_INV
            asm volatile("buffer_inv sc1" ::: "memory");
            XB_SPIN(xb_ld(&bar[XB_XGEN(b.x)]) == gen, bar);
            asm volatile("s_waitcnt vmcnt(0)" ::: "memory");
#else
            XB_SPIN(xb_ld(&bar[XB_XGEN(b.x)]) == gen, bar);
            __builtin_amdgcn_fence(__ATOMIC_ACQUIRE, "agent");
            asm volatile("s_waitcnt vmcnt(0)" ::: "memory");
#endif
        }
#if SEAM_PROBE == 1
        if (b.probe) atomicAdd(&bar[8192 - 4096], (unsigned)__builtin_amdgcn_s_memrealtime() - seam_t0);
#endif
    }
    __syncthreads();
}

__device__ __forceinline__ void xcd_local_barrier(const XcdBarrier& b) {
    asm volatile("s_waitcnt vmcnt(0)" ::: "memory");
    __syncthreads();
    if (threadIdx.x == 0) {
        unsigned* bar = b.bar;
        __builtin_amdgcn_s_waitcnt(0);
        const unsigned old = __hip_atomic_fetch_add(&bar[XB_LSUB(b.x)], 1u, __ATOMIC_RELAXED, __HIP_MEMORY_SCOPE_WORKGROUP);
        asm volatile("buffer_inv sc1" ::: "memory");
        const unsigned target = ((old >> 5) + 1u) * 32u;
        if (old + 1u != target) XB_SPIN(xb_ld(&bar[XB_LSUB(b.x)]) < target, bar);
        asm volatile("s_waitcnt vmcnt(0)" ::: "memory");
    }
    __syncthreads();
}

namespace fa {
typedef short bf16x8 __attribute__((ext_vector_type(8)));
typedef short s16x4 __attribute__((ext_vector_type(4)));
typedef float f32x16 __attribute__((ext_vector_type(16)));
typedef unsigned short bf16;
constexpr int SHM_V = 16384;
constexpr int V_OFF = 0;
constexpr int K_OFF = 2 * SHM_V;
constexpr int SCR_OFF = K_OFF + 2 * 24576;
constexpr float THR = 8.f;

__device__ __forceinline__ int v_rd_base(int lane) { return ((lane & 3) << 3) | (((lane >> 2) & 3) << 6) | (((lane >> 4) & 1) << 5) | (((lane >> 5) & 1) << 8); }
constexpr int v_rd_off(int d0, int ks, int half) { return d0 * 512 + ks * 4096 + half * 2048; }
__device__ __forceinline__ int crow(int r, int hi) { return (r & 3) + 8 * (r >> 2) + 4 * hi; }
__device__ __forceinline__ unsigned cvtpk(float lo, float hi) { unsigned r; asm volatile("v_cvt_pk_bf16_f32 %0, %1, %2" : "=v"(r) : "v"(lo), "v"(hi)); return r; }

template <int DQK>
__device__ __forceinline__ void qkt(f32x16& p0, f32x16& p1, const LAS unsigned char* kbuf, int r32, int hi, const bf16x8* qr) {
    p0 = f32x16{}; p1 = f32x16{};
    __builtin_amdgcn_s_setprio(1);
    if constexpr (DQK == 192) {
        const int x = (r32 >> 1) & 7; const LAS unsigned char* kb[4];
#pragma unroll
        for (int e = 0; e < 4; ++e) kb[e] = kbuf + r32 * 384 + (((2 * e + hi) ^ x) << 4);
#pragma unroll
        for (int d0 = 0; d0 < 12; ++d0) { const LAS unsigned char* a = kb[d0 & 3] + (d0 >> 2) * 128;
            const bf16x8 b0 = *(const LAS bf16x8*)a, b1 = *(const LAS bf16x8*)(a + 32 * 384);
            p0 = __builtin_amdgcn_mfma_f32_32x32x16_bf16(b0, qr[d0], p0, 0, 0, 0);
            p1 = __builtin_amdgcn_mfma_f32_32x32x16_bf16(b1, qr[d0], p1, 0, 0, 0); }
    } else {
        const int x = r32 & 7; const LAS unsigned char* kb[4];
#pragma unroll
        for (int e = 0; e < 4; ++e) kb[e] = kbuf + r32 * 256 + (((2 * e + hi) ^ x) << 4);
#pragma unroll
        for (int d0 = 0; d0 < 8; ++d0) { const LAS unsigned char* a = kb[d0 & 3] + (d0 >> 2) * 128;
            const bf16x8 b0 = *(const LAS bf16x8*)a, b1 = *(const LAS bf16x8*)(a + 32 * 256);
            p0 = __builtin_amdgcn_mfma_f32_32x32x16_bf16(b0, qr[d0], p0, 0, 0, 0);
            p1 = __builtin_amdgcn_mfma_f32_32x32x16_bf16(b1, qr[d0], p1, 0, 0, 0); }
    }
    __builtin_amdgcn_s_setprio(0);
}
__device__ __forceinline__ void pv_tile(f32x16* o, unsigned vb0, bf16x8 pa0, bf16x8 pa1, bf16x8 pa2, bf16x8 pa3) {
#define TRRD(dst, off) asm volatile("ds_read_b64_tr_b16 %0, %1 offset:%2" : "=&v"(dst) : "v"(vb0), "i"(off) : "memory")
#define PV_D0(d0) do { s16x4 l0, l1, l2, l3, h0, h1, h2, h3; constexpr int b_ = v_rd_off(d0, 0, 0); \
        TRRD(l0, b_); TRRD(h0, b_ + 2048); TRRD(l1, b_ + 4096); TRRD(h1, b_ + 6144); TRRD(l2, b_ + 8192); TRRD(h2, b_ + 10240); TRRD(l3, b_ + 12288); TRRD(h3, b_ + 14336); \
        asm volatile("s_waitcnt lgkmcnt(0)" ::: "memory"); __builtin_amdgcn_sched_barrier(0); \
        o[d0] = __builtin_amdgcn_mfma_f32_32x32x16_bf16(pa0, (bf16x8){l0[0], l0[1], l0[2], l0[3], h0[0], h0[1], h0[2], h0[3]}, o[d0], 0, 0, 0);   \
        o[d0] = __builtin_amdgcn_mfma_f32_32x32x16_bf16(pa1, (bf16x8){l1[0], l1[1], l1[2], l1[3], h1[0], h1[1], h1[2], h1[3]}, o[d0], 0, 0, 0);   \
        o[d0] = __builtin_amdgcn_mfma_f32_32x32x16_bf16(pa2, (bf16x8){l2[0], l2[1], l2[2], l2[3], h2[0], h2[1], h2[2], h2[3]}, o[d0], 0, 0, 0);   \
        o[d0] = __builtin_amdgcn_mfma_f32_32x32x16_bf16(pa3, (bf16x8){l3[0], l3[1], l3[2], l3[3], h3[0], h3[1], h3[2], h3[3]}, o[d0], 0, 0, 0); } while (0)
    __builtin_amdgcn_s_setprio(1);
    PV_D0(0); PV_D0(1); PV_D0(2); PV_D0(3);
    __builtin_amdgcn_s_setprio(0);
#undef PV_D0
#undef TRRD
}

struct UnitArgs {
    const bf16* Q; size_t qs;
    const bf16* K; size_t ks;
    const bf16* Kr; size_t krs;
    const bf16* V; size_t vs;
    bf16* O; size_t os;
    float* lse; size_t ls;
    int q0;
    int W;
    float scale;
    float bias;
    int rev;
    const float* rope;
};

template <int DQK, bool ALIBI>
__device__ __forceinline__ void attn_unit(LAS unsigned char* lds, const UnitArgs& u) {
    constexpr int KROW = DQK * 2, SHM_K = 64 * KROW, NKP = SHM_K / 8192, CPR = DQK / 8;
    const int tid = pg8::opaque_tid(), wid = __builtin_amdgcn_readfirstlane(tid >> 6), lane = tid & 63, r32 = lane & 31, hi = lane >> 5;
    const int W = u.W, q0 = u.q0;
    const int lowk = q0 - W + 1, j_lo = lowk > 0 ? lowk / 64 : 0, j_hi = (q0 + 255) / 64 + 1, NT = j_hi - j_lo;
    const int qlo = q0 + wid * 32;
    const float C2 = 1.4426950408889634f * u.scale;
    bf16x8 qr[DQK / 16];
    { const bf16* qp = u.Q + (size_t)(qlo + r32) * u.qs + hi * 8;
#pragma unroll
      for (int d0 = 0; d0 < DQK / 16; ++d0) qr[d0] = *(const bf16x8*)(qp + d0 * 16); }
    if constexpr (DQK == 192) { if (u.rope) {
#pragma unroll
        for (int d0 = 8; d0 < 10; ++d0) { const pg8::f32x4* tp = (const pg8::f32x4*)(u.rope + ((size_t)(qlo + r32) * 32 + 16 * (d0 - 8) + 8 * hi) * 2);
            pg8::f32x4 cs[4];
#pragma unroll
            for (int k = 0; k < 4; ++k) cs[k] = tp[k];
            bf16x8 a = qr[d0], b = qr[d0 + 2];
#pragma unroll
            for (int e = 0; e < 8; e += 2) { const pg8::f32x4 c = cs[e >> 1];
                const float a0 = __builtin_bit_cast(float, (unsigned)(unsigned short)a[e] << 16), a1 = __builtin_bit_cast(float, (unsigned)(unsigned short)a[e + 1] << 16);
                const float b0 = __builtin_bit_cast(float, (unsigned)(unsigned short)b[e] << 16), b1 = __builtin_bit_cast(float, (unsigned)(unsigned short)b[e + 1] << 16);
                const unsigned na = cvtpk(a0 * c[0] - b0 * c[1], a1 * c[2] - b1 * c[3]), nb = cvtpk(a0 * c[1] + b0 * c[0], a1 * c[3] + b1 * c[2]);
                a[e] = (short)(na & 0xffffu); a[e + 1] = (short)(na >> 16); b[e] = (short)(nb & 0xffffu); b[e + 1] = (short)(nb >> 16); }
            qr[d0] = a; qr[d0 + 2] = b; } } }
    const char* ksrc[NKP]; long kstep[NKP]; const char* vsrc[2];
    const int jt0 = u.rev ? (j_lo + NT - 1) : j_lo;
    const long dirn = u.rev ? -1 : 1;
#pragma unroll
    for (int i = 0; i < NKP; ++i) { const int L = (wid * NKP + i) * 64 + lane, row = L / CPR, cs = L % CPR;
        const int chunk = (DQK == 192) ? (cs ^ ((row >> 1) & 7)) : (cs ^ (row & 7));
        if (DQK == 192 && chunk >= 16) { ksrc[i] = (const char*)(u.Kr + (size_t)(jt0 * 64 + row) * u.krs + (chunk - 16) * 8); kstep[i] = dirn * (long)(64 * u.krs * 2); }
        else { ksrc[i] = (const char*)(u.K + (size_t)(jt0 * 64 + row) * u.ks + chunk * 8); kstep[i] = dirn * (long)(64 * u.ks * 2); } }
#pragma unroll
    for (int i = 0; i < 2; ++i) { const int L = (wid * 2 + i) * 64 + lane, sub = L >> 5, rem = L & 31, kk = (sub >> 2) * 8 + (rem >> 2);
        const int k = kk, c = (sub & 3) * 32 + (rem & 3) * 8;
        vsrc[i] = (const char*)(u.V + (size_t)(jt0 * 64 + k) * u.vs + c); }
    const long vstep = dirn * (long)(64 * u.vs * 2);
#define FA_ISSUE(buf) do { \
        _Pragma("unroll") for (int i_ = 0; i_ < NKP; ++i_) { __builtin_amdgcn_global_load_lds((const unsigned*)ksrc[i_], (LAS unsigned*)(lds + K_OFF + (buf) * SHM_K + (wid * NKP + i_) * 1024), 16, 0, 0); ksrc[i_] += kstep[i_]; } \
        _Pragma("unroll") for (int i_ = 0; i_ < 2; ++i_) { __builtin_amdgcn_global_load_lds((const unsigned*)vsrc[i_], (LAS unsigned*)(lds + V_OFF + (buf) * SHM_V + (wid * 2 + i_) * 1024), 16, 0, 0); vsrc[i_] += vstep; } } while (0)
    LAS float* scr = (LAS float*)(lds + SCR_OFF) + wid * 64; LAS float* li_l = scr; LAS float* al_l = scr + 32;
    const unsigned vbase = (unsigned)(size_t)(lds + V_OFF) + (unsigned)v_rd_base(lane);
    float m_reg = -1e30f, l_reg = 0.f; f32x16 o[4] = {};
    FA_ISSUE(0);
    for (int t = 0; t < NT; ++t) {
        asm volatile("s_waitcnt vmcnt(0)" ::: "memory"); __builtin_amdgcn_s_barrier(); asm volatile("" ::: "memory");
        const int b = t & 1;
        const int kb = (u.rev ? (j_lo + NT - 1 - t) : (j_lo + t)) * 64;
        const bool act = (kb <= qlo + 31) && (kb + 63 >= qlo - W + 1);
        if (act) {
            f32x16 p0, p1;
            qkt<DQK>(p0, p1, lds + K_OFF + b * SHM_K, r32, hi, qr);
            const int dq = qlo + r32 - kb - 4 * hi;
            if (ALIBI) { const float dqf = (float)dq, nb = -u.bias;
#pragma unroll
                for (int r = 0; r < 16; ++r) { const float c = (float)((r & 3) + 8 * (r >> 2));
                    p0[r] = fmaf(nb, dqf - c, p0[r]); p1[r] = fmaf(nb, dqf - c - 32.f, p1[r]); } }
            if (kb + 63 > qlo || kb <= qlo + 31 - W) { const float NEG = -__builtin_inff();
#pragma unroll
                for (int r = 0; r < 16; ++r) { const int c = (r & 3) + 8 * (r >> 2);
                    if ((unsigned)(dq - c) >= (unsigned)W) p0[r] = NEG;
                    if ((unsigned)(dq - c - 32) >= (unsigned)W) p1[r] = NEG; } }
            float pmax = p0[0];
#pragma unroll
            for (int r = 1; r < 16; ++r) pmax = fmaxf(pmax, p0[r]);
#pragma unroll
            for (int r = 0; r < 16; ++r) pmax = fmaxf(pmax, p1[r]);
            { auto rr = __builtin_amdgcn_permlane32_swap(__float_as_uint(pmax), __float_as_uint(pmax), false, false);
              pmax = fmaxf(__uint_as_float(rr[0]), __uint_as_float(rr[1])); }
            float mn, alpha;
            if (__builtin_expect(__all((pmax - m_reg) * u.scale <= THR), 1)) { mn = m_reg; alpha = 1.f; }
            else { mn = fmaxf(m_reg, pmax); alpha = __builtin_amdgcn_exp2f((m_reg - mn) * C2); m_reg = mn; }
            const float mnL = -mn * C2;
#pragma unroll
            for (int r = 0; r < 16; ++r) { p0[r] = __builtin_amdgcn_exp2f(fmaf(p0[r], C2, mnL)); p1[r] = __builtin_amdgcn_exp2f(fmaf(p1[r], C2, mnL)); }
            if (t + 1 < NT) FA_ISSUE(b ^ 1);
            float ps = 0.f;
#pragma unroll
            for (int r = 0; r < 16; ++r) ps += p0[r];
#pragma unroll
            for (int r = 0; r < 16; ++r) ps += p1[r];
            { auto rr = __builtin_amdgcn_permlane32_swap(__float_as_uint(ps), __float_as_uint(ps), false, false);
              ps = __uint_as_float(rr[0]) + __uint_as_float(rr[1]); }
            l_reg = l_reg * alpha + ps;
            bf16x8 pa0, pa1, pa2, pa3;
#define PK4(P, B_, OUT) do { pg8::u32x4 w = {cvtpk(P[B_+0], P[B_+1]), cvtpk(P[B_+2], P[B_+3]), cvtpk(P[B_+4], P[B_+5]), cvtpk(P[B_+6], P[B_+7])}; OUT = __builtin_bit_cast(bf16x8, w); } while (0)
            PK4(p0, 0, pa0); PK4(p0, 8, pa1); PK4(p1, 0, pa2); PK4(p1, 8, pa3);
#undef PK4
            if (__any(alpha < 1.f)) { if (hi == 0) al_l[r32] = alpha; asm volatile("s_waitcnt lgkmcnt(0)" ::: "memory");
#pragma unroll
                for (int r = 0; r < 16; ++r) { const float a = al_l[crow(r, hi)];
#pragma unroll
                    for (int d_ = 0; d_ < 4; ++d_) o[d_][r] *= a; }
                asm volatile("s_waitcnt lgkmcnt(0)" ::: "memory"); }
            pv_tile(o, vbase + b * SHM_V, pa0, pa1, pa2, pa3);
        } else if (t + 1 < NT) FA_ISSUE(b ^ 1);
    }
#undef FA_ISSUE
    if (hi == 0) li_l[r32] = l_reg; asm volatile("s_waitcnt lgkmcnt(0)" ::: "memory");
    bf16* Ow = u.O + (size_t)qlo * u.os;
#pragma unroll
    for (int r = 0; r < 16; ++r) { const int orow = crow(r, hi); const float rl = __builtin_amdgcn_rcpf(li_l[orow]);
#pragma unroll
        for (int d0 = 0; d0 < 4; ++d0) { const float v = o[d0][r] * rl;
            const float vn = __int_as_float(__builtin_amdgcn_update_dpp(0, __float_as_int(v), 0xB1, 0xF, 0xF, false));
            if ((r32 & 1) == 0) *(unsigned*)(Ow + (size_t)orow * u.os + d0 * 32 + r32) = cvtpk(v, vn); } }
    if (u.lse != nullptr && hi == 0) u.lse[(size_t)(qlo + r32) * u.ls] = m_reg * u.scale + __logf(l_reg);
    asm volatile("s_waitcnt lgkmcnt(0)" ::: "memory"); __builtin_amdgcn_s_barrier(); asm volatile("" ::: "memory");
}
}


constexpr int SEQ = 8192, DM = 2048, FF = 5632, NHEAD = 16, HD = 128;
constexpr int NQKV = 3 * DM, NUP = 2 * FF;
constexpr int KVR = 512, NKV1 = 768  , NUKV = 4096, QLR = 512, NQ = NHEAD * 192;
constexpr float EPS = 1e-6f;

constexpr size_t MiB = 1u << 20;
constexpr size_t WS_CTL = 0, CTL_ZERO_BYTES = 64 * 1024;
constexpr size_t WS_ROPE = 1 * MiB;
constexpr size_t WS_W = 4 * MiB;
constexpr size_t WGU_B = (size_t)NUP * DM * 2, WD_B = (size_t)DM * FF * 2, WFFN_B = WGU_B + WD_B;
constexpr size_t WS_WA = WS_W + 8 * WFFN_B, WA_B = 32 * MiB;
constexpr size_t WS_WKV = WS_WA + 2 * WA_B;
constexpr size_t WS_WB = WS_WKV + 8 * MiB, WB_B = 16 * MiB;
constexpr size_t WS_HB = WS_WB + 2 * WB_B;
constexpr size_t WS_ACT = WS_HB + 32 * MiB;
constexpr size_t WS_QKV = WS_ACT + 88 * MiB;
constexpr size_t WS_AO = WS_QKV + 96 * MiB;
constexpr size_t WS_KV = WS_AO + 32 * MiB;
constexpr size_t WS_KR = WS_KV + 64 * MiB;
constexpr size_t WS_CB = WS_KR + 1 * MiB;
constexpr size_t WS_OG = WS_CB + 8 * MiB;
constexpr size_t WS_LSE = WS_OG + 96 * MiB;
constexpr size_t WS_SSQ = WS_LSE + 2 * MiB;
constexpr size_t WS_XL = WS_SSQ + 1 * MiB;
constexpr size_t WS_END = WS_XL + 32 * MiB;
static_assert(WGU_B == 44 * MiB && WD_B == 22 * MiB, "weight sizes");
constexpr int CW_TMO = 0, CW_BAR = 4096;
constexpr int CW_PANEL = 8448;

constexpr int RING_OFF = 0, RING_BYTES = 131072;
constexpr int LDSCTL_OFF = RING_BYTES, MISC_OFF = LDSCTL_OFF + 320;
constexpr int TAB_OFF = RING_BYTES + 1024;
constexpr int LDS_BYTES = 147456;
constexpr int NWAVES = 8;
#ifndef TAIL_PCT
#define TAIL_PCT 100
#endif
constexpr int TAIL_C0 = ((SEQ / 256) * (NUP / 256)) % 256;

typedef unsigned short bf16;
typedef unsigned v4u __attribute__((ext_vector_type(4)));
typedef unsigned v2u __attribute__((ext_vector_type(2)));
typedef float f32x4 __attribute__((ext_vector_type(4)));
typedef float f32x2 __attribute__((ext_vector_type(2)));
#define LDS_WAIT() asm volatile("s_waitcnt lgkmcnt(0)" ::: "memory")
#define VM_WAIT() asm volatile("s_waitcnt vmcnt(0)" ::: "memory")
__device__ __forceinline__ unsigned f2bf(float f) { unsigned u = __builtin_bit_cast(unsigned, f); return (u + 0x7fffu + ((u >> 16) & 1u)) >> 16; }
__device__ __forceinline__ unsigned pk2(float lo, float hi) { return f2bf(lo) | (f2bf(hi) << 16); }
__device__ __forceinline__ float bflo(unsigned u) { return __builtin_bit_cast(float, u << 16); }
__device__ __forceinline__ float bfhi(unsigned u) { return __builtin_bit_cast(float, u & 0xffff0000u); }
__device__ __forceinline__ float wave_sum(float v) {
#pragma unroll
    for (int o = 1; o < 64; o <<= 1) v += __shfl_xor(v, o);
    return v;
}

struct Frame { LAS unsigned char* lds; unsigned* ctl; int tid, lane, wave, G, gw, NGW; };

__device__ __forceinline__ void tr_item(const float* W, int ldw, bf16* WT, int K, int drow0, int k0, int n0, LAS float* scr, int lane, const float* gain) {
    float tv[32];
    { const float* wp = W + (size_t)(k0 + (lane >> 5)) * ldw + n0 + (lane & 31);
#pragma unroll
      for (int i = 0; i < 32; ++i) tv[i] = __builtin_nontemporal_load(wp + (size_t)(2 * i) * ldw); }
#pragma unroll
    for (int i = 0; i < 32; ++i) scr[(2 * i + (lane >> 5)) * 33 + (lane & 31)] = tv[i];
    LDS_WAIT(); asm volatile("" ::: "memory");
    const int c = lane & 7;
    f32x4 g0 = {1.f, 1.f, 1.f, 1.f}, g1 = {1.f, 1.f, 1.f, 1.f};
    if (gain) { g0 = *(const f32x4*)(gain + k0 + 8 * c); g1 = *(const f32x4*)(gain + k0 + 8 * c + 4); }
#pragma unroll
    for (int j = 0; j < 4; ++j) { const int n = (lane >> 3) + 8 * j; const LAS float* s = scr + (8 * c) * 33 + n;
        v4u o; o.x = pk2(s[0 * 33] * g0.x, s[1 * 33] * g0.y); o.y = pk2(s[2 * 33] * g0.z, s[3 * 33] * g0.w); o.z = pk2(s[4 * 33] * g1.x, s[5 * 33] * g1.y); o.w = pk2(s[6 * 33] * g1.z, s[7 * 33] * g1.w);
        __builtin_nontemporal_store(o, (v4u*)(WT + (size_t)(drow0 + n) * K + k0 + 8 * c)); }
    LDS_WAIT(); asm volatile("" ::: "memory");
}
__device__ __forceinline__ void tr_mat(const float* W, int K, int N, bf16* WT, int rowoff, int mode, int r, LAS float* scr, int lane, const float* gain) {
    const int nbk = N / 32, kb = r / nbk, nb = r % nbk, n0 = nb * 32;
    const int drow0 = rowoff + (mode ? ((n0 >> 7) * 256 + (n0 & 127)) : n0);
    tr_item(W, N, WT, K, drow0, kb * 64, n0, scr, lane, gain);
}

struct Args { const float* in[23]; float* out; unsigned char* ws; int ph_lo, ph_hi; };

constexpr int I_FFN1 = (DM / 64) * (FF / 32);
constexpr int I_FFN = 3 * I_FFN1;
constexpr int I_TAIL = (I_FFN * TAIL_PCT / 100) / 1024 * 1024;
__device__ __forceinline__ void conv_ffn(const Frame& F, const Args& a, int s, int gw, int ngw, int i0, int i1) {
    LAS float* scr = (LAS float*)(F.lds + RING_OFF + F.wave * 16384);
    const int layer = s >> 1, which = s & 1;
    bf16* wgu = (bf16*)(a.ws + WS_W + (size_t)s * WFFN_B); bf16* wd = (bf16*)(a.ws + WS_W + (size_t)s * WFFN_B + WGU_B);
    const float* gain = a.in[which ? 6 : 1] + (size_t)layer * DM;
    for (int it = i0 + gw; it < i1; it += ngw) {
        int r = it;
        if (r < I_FFN1) { tr_mat(a.in[which ? 7 : 2] + (size_t)layer * DM * FF, DM, FF, wgu, 0, 1, r, scr, F.lane, gain); continue; } r -= I_FFN1;
        if (r < I_FFN1) { tr_mat(a.in[which ? 8 : 3] + (size_t)layer * DM * FF, DM, FF, wgu, 128, 1, r, scr, F.lane, gain); continue; } r -= I_FFN1;
        tr_mat(a.in[which ? 9 : 4] + (size_t)layer * FF * DM, FF, DM, wd, 0, 0, r, scr, F.lane, nullptr);
    }
}
__device__ __forceinline__ void p0_prologue(const Frame& F, const Args& a) {
    LAS float* scr = (LAS float*)(F.lds + RING_OFF + F.wave * 16384);
    unsigned char* ws = a.ws;
    constexpr int I_QKV = (DM / 64) * (NQKV / 32), I_O = (DM / 64) * (DM / 32), I_A = I_QKV + I_O;
    constexpr int I_DKV = (DM / 64) * (KVR / 32), I_KR = (DM / 64) * (64 / 32), I_UK = (KVR / 64) * (DM / 32), I_KV = I_DKV + I_KR + 2 * I_UK;
    constexpr int I_DQ = (DM / 64) * (QLR / 32), I_UQ = (QLR / 64) * (NQ / 32), I_B = I_DQ + I_UQ + I_O;
    constexpr int NITEMS = 2 * I_A + I_KV + 2 * I_B;
    conv_ffn(F, a, 0, F.gw, F.NGW, 0, I_FFN);
    for (int s = 1; s < 8; ++s) conv_ffn(F, a, s, F.gw, F.NGW, I_TAIL, I_FFN);
    for (int it = F.gw; it < NITEMS; it += F.NGW) {
        int r = it;
        if (r < 2 * I_A) { const int l = r / I_A; r -= l * I_A;
            bf16* wqkv = (bf16*)(ws + WS_WA + (size_t)l * WA_B); bf16* wo = (bf16*)(ws + WS_WA + (size_t)l * WA_B + 24 * MiB);
            if (r < I_QKV) { tr_mat(a.in[10] + (size_t)l * DM * NQKV, DM, NQKV, wqkv, 0, 0, r, scr, F.lane, a.in[5] + (size_t)l * DM); continue; } r -= I_QKV;
            tr_mat(a.in[11] + (size_t)l * DM * DM, DM, DM, wo, 0, 0, r, scr, F.lane, nullptr); continue; }
        r -= 2 * I_A;
        if (r < I_KV) { bf16* wdkv = (bf16*)(ws + WS_WKV); bf16* wukv = (bf16*)(ws + WS_WKV + 3 * MiB);
            if (r < I_DKV) { tr_mat(a.in[13], DM, KVR, wdkv, 0, 0, r, scr, F.lane, a.in[12]); continue; } r -= I_DKV;
            if (r < I_KR) { tr_mat(a.in[15], DM, 64, wdkv, KVR, 0, r, scr, F.lane, a.in[12]); continue; } r -= I_KR;
            if (r < I_UK) { tr_mat(a.in[16], KVR, DM, wukv, 0, 0, r, scr, F.lane, nullptr); continue; } r -= I_UK;
            tr_mat(a.in[17], KVR, DM, wukv, DM, 0, r, scr, F.lane, nullptr); continue; }
        r -= I_KV;
        { const int l = r / I_B; r -= l * I_B;
            bf16* wdq = (bf16*)(ws + WS_WB + (size_t)l * WB_B); bf16* wuq = (bf16*)(ws + WS_WB + (size_t)l * WB_B + 2 * MiB); bf16* wo = (bf16*)(ws + WS_WB + (size_t)l * WB_B + 8 * MiB);
            if (r < I_DQ) { tr_mat(a.in[18] + (size_t)l * DM * QLR, DM, QLR, wdq, 0, 0, r, scr, F.lane, a.in[5] + (size_t)(2 + l) * DM); continue; } r -= I_DQ;
            if (r < I_UQ) { tr_mat(a.in[20] + (size_t)l * QLR * NQ, QLR, NQ, wuq, 0, 0, r, scr, F.lane, nullptr); continue; } r -= I_UQ;
            tr_mat(a.in[21] + (size_t)l * DM * DM, DM, DM, wo, 0, 0, r, scr, F.lane, nullptr); }
    }
    const int gt = blockIdx.x * (NWAVES * 64) + F.tid, NGT = F.G * NWAVES * 64;
    { v4u* z = (v4u*)(ws + WS_WKV + (size_t)576 * DM * 2); const v4u zero = {0u, 0u, 0u, 0u};
      for (int i = gt; i < (NKV1 - 576) * DM * 2 / 16; i += NGT) z[i] = zero; }
    { f32x2* tab = (f32x2*)(ws + WS_ROPE);
      for (int i = gt; i < SEQ * 32; i += NGT) { const int pos = i >> 5, j = i & 31;
          const float inv = 1.0f / exp2f((float)j * (13.287712379549449f / 32.0f));
          const float ang = (float)pos * inv;
          double t = (double)ang * 0.15915494309189535; t -= floor(t); const float tf = (float)t;
          f32x2 cs; cs.x = __builtin_amdgcn_cosf(tf); cs.y = __builtin_amdgcn_sinf(tf); tab[i] = cs; } }
    { bf16* xb = (bf16*)(ws + WS_HB); bf16* xl = (bf16*)(ws + WS_XL); float* ssq = (float*)(ws + WS_SSQ); const float* x = a.in[0];
      for (int m = F.gw; m < SEQ; m += F.NGW) {
          const f32x4* xr = (const f32x4*)(x + (size_t)m * DM) + F.lane; v2u* o = (v2u*)(xb + (size_t)m * DM) + F.lane; v2u* ol = (v2u*)(xl + (size_t)m * DM) + F.lane; float s = 0.f;
          f32x4 v[8];
#pragma unroll
          for (int j = 0; j < 8; ++j) v[j] = __builtin_nontemporal_load(xr + 64 * j);
#pragma unroll
          for (int j = 0; j < 8; ++j) { s += (v[j].x * v[j].x + v[j].y * v[j].y) + (v[j].z * v[j].z + v[j].w * v[j].w); v2u w; w.x = pk2(v[j].x, v[j].y); w.y = pk2(v[j].z, v[j].w); o[64 * j] = w;
              if (RESID_LO) { v2u wl; wl.x = pk2(v[j].x - bflo(w.x), v[j].y - bfhi(w.x)); wl.y = pk2(v[j].z - bflo(w.y), v[j].w - bfhi(w.y)); ol[64 * j] = wl; } }
          s = wave_sum(s);
          if (F.lane < 8) ssq[(size_t)m * 8 + F.lane] = (F.lane == 0) ? s : 0.f; } }
}
__device__ __forceinline__ void fill_rstd_tab(const Frame& F, const float* ssq, int fm256) {
    LAS float* tab = (LAS float*)(F.lds + TAB_OFF);
    for (int i = F.tid; i < 1024; i += NWAVES * 64) { const f32x4 a = *(const f32x4*)(ssq + (size_t)(fm256 + i) * 8), b = *(const f32x4*)(ssq + (size_t)(fm256 + i) * 8 + 4);
        const float s = ((a.x + a.y) + (a.z + a.w)) + ((b.x + b.y) + (b.z + b.w)); tab[i] = 1.0f / sqrtf(s * (1.0f / DM) + EPS); }
    __syncthreads();
}

__device__ __forceinline__ void norm_rows_bf16(const Frame& F, const float* x, const float* gain, bf16* out) {
    for (int m = F.gw; m < SEQ; m += F.NGW) {
        const f32x4* xr = (const f32x4*)(x + (size_t)m * DM) + F.lane; const f32x4* g4 = (const f32x4*)gain + F.lane;
        f32x4 v[8]; float s = 0.f;
#pragma unroll
        for (int j = 0; j < 8; ++j) { v[j] = xr[64 * j]; s += (v[j].x * v[j].x + v[j].y * v[j].y) + (v[j].z * v[j].z + v[j].w * v[j].w); }
        const float rstd = 1.0f / sqrtf(wave_sum(s) * (1.0f / DM) + EPS);
        v2u* o = (v2u*)(out + (size_t)m * DM) + F.lane;
#pragma unroll
        for (int j = 0; j < 8; ++j) { const f32x4 g = g4[64 * j]; v2u w; w.x = pk2(v[j].x * rstd * g.x, v[j].y * rstd * g.y); w.y = pk2(v[j].z * rstd * g.z, v[j].w * rstd * g.w); o[64 * j] = w; }
    }
}
__device__ __forceinline__ void norm_rows_f32(const Frame& F, const float* x, const float* gain, float* out) {
    for (int m = F.gw; m < SEQ; m += F.NGW) {
        const f32x4* xr = (const f32x4*)(x + (size_t)m * DM) + F.lane; const f32x4* g4 = (const f32x4*)gain + F.lane;
        f32x4 v[8]; float s = 0.f;
#pragma unroll
        for (int j = 0; j < 8; ++j) { v[j] = xr[64 * j]; s += (v[j].x * v[j].x + v[j].y * v[j].y) + (v[j].z * v[j].z + v[j].w * v[j].w); }
        const float rstd = 1.0f / sqrtf(wave_sum(s) * (1.0f / DM) + EPS);
        f32x4* o = (f32x4*)(out + (size_t)m * DM) + F.lane;
#pragma unroll
        for (int j = 0; j < 8; ++j) { const f32x4 g = g4[64 * j]; __builtin_nontemporal_store(v[j] * rstd * g, o + 64 * j); }
    }
}
template <int NS, int LD, bool KR>
__device__ __forceinline__ void latent_post(const Frame& F, const bf16* raw, const float* gain, bf16* cb, bf16* kr, const f32x2* ropetab, const float* ssq) {
    const int xs = (F.gw / NWAVES) & 7, lw = ((F.gw / NWAVES) >> 3) * NWAVES + F.wave;
    for (int m = 1024 * xs + lw; m < 1024 * (xs + 1); m += 256) {
        f32x4 v0 = {0.f, 0.f, 0.f, 0.f}, v1 = {0.f, 0.f, 0.f, 0.f}; float t1 = 0.f, t2 = 0.f;
        const f32x4 qa = *(const f32x4*)(ssq + (size_t)m * 8), qb = *(const f32x4*)(ssq + (size_t)m * 8 + 4);
        const float rsx = 1.0f / sqrtf((((qa.x + qa.y) + (qa.z + qa.w)) + ((qb.x + qb.y) + (qb.z + qb.w))) * (1.0f / DM) + EPS);
#pragma unroll
        for (int p = 0; p < NS; ++p) { const bf16* rr = raw + (size_t)p * SEQ * LD + (size_t)m * LD;
            const v4u w = __builtin_nontemporal_load((const v4u*)(rr + 8 * F.lane));
            v0 += (f32x4){bflo(w.x), bfhi(w.x), bflo(w.y), bfhi(w.y)}; v1 += (f32x4){bflo(w.z), bfhi(w.z), bflo(w.w), bfhi(w.w)};
            if (KR) { t1 += bflo((unsigned)rr[512 + (F.lane & 31)]); t2 += bflo((unsigned)rr[544 + (F.lane & 31)]); } }
        v0 *= rsx; v1 *= rsx; t1 *= rsx; t2 *= rsx;
        const float s = (v0.x * v0.x + v0.y * v0.y) + (v0.z * v0.z + v0.w * v0.w) + (v1.x * v1.x + v1.y * v1.y) + (v1.z * v1.z + v1.w * v1.w);
        const float rstd = 1.0f / sqrtf(wave_sum(s) * (1.0f / 512.0f) + EPS);
        const f32x4 g0 = *(const f32x4*)(gain + 8 * F.lane), g1 = *(const f32x4*)(gain + 8 * F.lane + 4);
        v4u w; w.x = pk2(v0.x * rstd * g0.x, v0.y * rstd * g0.y); w.y = pk2(v0.z * rstd * g0.z, v0.w * rstd * g0.w);
        w.z = pk2(v1.x * rstd * g1.x, v1.y * rstd * g1.y); w.w = pk2(v1.z * rstd * g1.z, v1.w * rstd * g1.w);
        *(v4u*)(cb + (size_t)m * 512 + 8 * F.lane) = w;
        if (KR) { const f32x2 cs = ropetab[m * 32 + (F.lane & 31)];
            const float r = (F.lane < 32) ? (t1 * cs.x - t2 * cs.y) : (t1 * cs.y + t2 * cs.x);
            kr[(size_t)m * 64 + F.lane] = (bf16)f2bf(r); }
    }
}
__device__ __forceinline__ void attn_dilated_phase(LAS unsigned char* lds, const bf16* qkv, bf16* og, float* lse, int G, int bx) {
    for (int uix = bx; uix < 3 * 512; uix += G) {
        const int g = uix >> 9, rem = uix & 511, h = rem & 15, rb = rem >> 4, d = 1 << (2 * g), r = rb & (d - 1), b = rb >> (2 * g);
        const float slope = exp2f(-0.5f * (float)(h + 1)), scale = 0.08838834764831845f;
        fa::UnitArgs u;
        u.Q = qkv + (size_t)r * NQKV + h * HD; u.qs = (size_t)d * NQKV; u.K = u.Q + DM; u.ks = u.qs; u.Kr = nullptr; u.krs = 0; u.V = u.Q + 2 * DM; u.vs = u.qs;
        u.O = og + (size_t)g * SEQ * DM + (size_t)r * DM + h * HD; u.os = (size_t)d * DM; u.lse = lse + (size_t)g * SEQ * NHEAD + r * NHEAD + h; u.ls = (size_t)d * NHEAD;
        u.q0 = b * 256; u.W = 129; u.scale = scale; u.bias = slope * (float)d / scale; u.rope = nullptr; u.rev = 0;
        fa::attn_unit<128, true>(lds, u);
    }
}
__device__ __forceinline__ void attn_combine_phase(const Frame& F, const bf16* og, const float* lse, bf16* ao) {
    const int xs = (F.gw / NWAVES) & 7, lw = ((F.gw / NWAVES) >> 3) * NWAVES + F.wave;
    for (int p = 1024 * xs + lw; p < 1024 * (xs + 1); p += 256) {
        v4u va[4], vb[4], vc[4]; float l0[4], l1[4], l2[4];
#pragma unroll
        for (int j = 0; j < 4; ++j) { const int c0 = (j * 64 + F.lane) * 8, h = c0 >> 7;
            l0[j] = lse[(size_t)p * NHEAD + h]; l1[j] = lse[(size_t)(SEQ + p) * NHEAD + h]; l2[j] = lse[(size_t)(2 * SEQ + p) * NHEAD + h];
            va[j] = __builtin_nontemporal_load((const v4u*)(og + (size_t)p * DM + c0)); vb[j] = __builtin_nontemporal_load((const v4u*)(og + (size_t)(SEQ + p) * DM + c0)); vc[j] = __builtin_nontemporal_load((const v4u*)(og + (size_t)(2 * SEQ + p) * DM + c0)); }
#pragma unroll
        for (int j = 0; j < 4; ++j) { const int c0 = (j * 64 + F.lane) * 8;
            const float mx = fmaxf(l0[j], fmaxf(l1[j], l2[j])); float w0 = __expf(l0[j] - mx), w1 = __expf(l1[j] - mx), w2 = __expf(l2[j] - mx);
            const float inv = 1.0f / (w0 + w1 + w2); w0 *= inv; w1 *= inv; w2 *= inv;
            v4u o;
#pragma unroll
            for (int e = 0; e < 4; ++e) o[e] = pk2(w0 * bflo(va[j][e]) + w1 * bflo(vb[j][e]) + w2 * bflo(vc[j][e]), w0 * bfhi(va[j][e]) + w1 * bfhi(vb[j][e]) + w2 * bfhi(vc[j][e]));
            *(v4u*)(ao + (size_t)p * DM + c0) = o; }
    }
}
__device__ __forceinline__ void attn_mla_phase(LAS unsigned char* lds, const bf16* q, const bf16* kv, const bf16* kr, bf16* ao, const float* rope, int G, int bx) {
    for (int it = bx; it < 256; it += G) {
        const int xcd = it & 7, idx = it >> 3, h = xcd * 2 + (idx >> 4), pr = idx & 15;
        for (int pass = 0; pass < 2; ++pass) {
            fa::UnitArgs u;
            u.Q = q + h * 192; u.qs = NQ; u.K = kv + h * HD; u.ks = NUKV; u.Kr = kr; u.krs = 64; u.V = kv + DM + h * HD; u.vs = NUKV;
            u.O = ao + h * HD; u.os = DM; u.lse = nullptr; u.ls = 0; u.q0 = (pass ? pr : 31 - pr) * 256;     u.W = 1 << 30; u.scale = 0.07216878364870322f; u.bias = 0.f; u.rope = rope; u.rev = pass;
            fa::attn_unit<192, false>(lds, u);
        }
    }
}

typedef const volatile Args __attribute__((address_space(4))) KArgs;
__global__ void __launch_bounds__(NWAVES * 64, 2) mk_fwd(Args args) {
    KArgs* const ka = (KArgs*)__builtin_amdgcn_kernarg_segment_ptr();
#define IN(k) ((const float*)ka->in[k])
    extern __shared__ __attribute__((aligned(16))) unsigned char lds_raw[];
    LAS unsigned char* const LDSB = (LAS unsigned char*)lds_raw;
    volatile LAS unsigned* MISC = (volatile LAS unsigned*)(LDSB + MISC_OFF);
    unsigned char* ws = args.ws;
    unsigned* const CTL = (unsigned*)(ws + WS_CTL);
    for (int u = threadIdx.x; u < (LDS_BYTES - LDSCTL_OFF) / 4; u += NWAVES * 64) ((LAS unsigned*)(LDSB + LDSCTL_OFF))[u] = 0u;
    __syncthreads();
    XcdBarrier bar; bar.bar = CTL + CW_BAR; bar.x = 0; bar.st = nullptr;
    if (!MK_PER_PHASE) bar = xcd_barrier_post(CTL + CW_BAR, MISC + 8);
    const int lo = args.ph_lo, hi = args.ph_hi;
    int ph = 0;
#if SEAM_PROBE
#define SEAM_T0(kind) bar.probe = (SEAM_MASK >> (kind)) & 1u;
#define SEAM_T1(kind)
#else
#define SEAM_T0(kind)
#define SEAM_T1(kind)
#endif
#define PH_BEGIN(kind) if (ph >= lo && ph < hi) { const unsigned long long pt0_ = ((PROBE_MASK >> (kind)) & 1u) ? __builtin_amdgcn_s_memrealtime() : 0ull; Frame F; F.lds = LDSB; F.ctl = CTL; F.tid = pg8::opaque_tid(); F.lane = F.tid & 63; F.wave = __builtin_amdgcn_readfirstlane(F.tid >> 6); F.G = gridDim.x; \
    const int bx = (ph == 0) ? (int)blockIdx.x : __builtin_amdgcn_readfirstlane((int)MISC[12]);     \
    F.gw = bx * NWAVES + F.wave; F.NGW = F.G * NWAVES;
#define PH_END(kind, LOCAL) if ((PROBE_MASK >> (kind)) & 1u) { const unsigned long long pt1_ = __builtin_amdgcn_s_memrealtime(); while (__builtin_amdgcn_s_memrealtime() - pt1_ < pt1_ - pt0_) __builtin_amdgcn_s_sleep(8); } \
    } ++ph; if (!MK_PER_PHASE && ph > lo && ph < hi) { SEAM_T0(kind) if ((LOCAL) && __builtin_amdgcn_readfirstlane((int)MISC[11]) != 0) xcd_local_barrier(bar); else xcd_barrier(bar); SEAM_T1(kind) if (PROBE_MASK >> 31) xcd_barrier(bar); }

    float* X = args.out;
    bf16* XL = (bf16*)(ws + WS_XL);
    bf16* XB = (bf16*)(ws + WS_HB); float* SSQ = (float*)(ws + WS_SSQ); bf16* ACT = (bf16*)(ws + WS_ACT); bf16* QKV = (bf16*)(ws + WS_QKV); bf16* AO = (bf16*)(ws + WS_AO);
    bf16* KV = (bf16*)(ws + WS_KV); bf16* KR = (bf16*)(ws + WS_KR); bf16* CB = (bf16*)(ws + WS_CB);
    bf16* RAW = (bf16*)(ws + WS_OG + 32 * MiB); bf16* RAWKV = (bf16*)(ws + WS_OG); bf16* OG = (bf16*)(ws + WS_OG); float* LSE = (float*)(ws + WS_LSE);
    const f32x2* ROPETAB = (const f32x2*)(ws + WS_ROPE);

    PH_BEGIN(0) p0_prologue(F, args); PH_END(0, 0)

    for (int s = 0; s < 8; ++s) {
        const int layer = s >> 1, which = s & 1;
        if (s == 4) {
            PH_BEGIN(13) { pg8::Gemm g{XB, (const bf16*)(ws + WS_WKV), DM, DM, DM / 2}; pg8::StaticOrder S; S.init(SEQ, NKV1, 2, F.G, bx);
                       pg8::EpiBf16 E{RAWKV, NKV1, nullptr, 0, (size_t)SEQ * NKV1};
                       pg8::gemm_phase<pg8::EpiBf16, pg8::StaticOrder, true, true>(F.lds + RING_OFF, g, S, E); } PH_END(13, 1)
            PH_BEGIN(14) latent_post<2, NKV1, true>(F, RAWKV, IN(14), CB, KR, ROPETAB, SSQ); PH_END(14, 1)
            PH_BEGIN(15) { pg8::Gemm g{CB, (const bf16*)(ws + WS_WKV + 3 * MiB), KVR, KVR, KVR}; pg8::StaticOrder S; S.init(SEQ, NUKV, 1, F.G, bx);
                       pg8::EpiBf16 E{KV, NUKV, nullptr, 0};
                       pg8::gemm_phase<pg8::EpiBf16, pg8::StaticOrder, true, true>(F.lds + RING_OFF, g, S, E); } PH_END(15, 1)
        }
        PH_BEGIN(1) { pg8::Gemm g{XB, (const bf16*)(ws + WS_W + (size_t)s * WFFN_B), DM, DM, DM}; pg8::StaticOrder S; S.init(SEQ, NUP, 1, F.G, bx);
                   pg8::Unit u0; const int fm256 = S.next(0, u0) ? (u0.pm & ~3) * 256 : 0; fill_rstd_tab(F, SSQ, fm256);
                   pg8::EpiSwiGLU E{ACT, FF, (const LAS float*)(F.lds + TAB_OFF), fm256};
                   pg8::gemm_phase<pg8::EpiSwiGLU, pg8::StaticOrder, true, true>(F.lds + RING_OFF, g, S, E);
                   if (s < 7 && bx >= TAIL_C0) conv_ffn(F, args, s + 1, (bx - TAIL_C0) * NWAVES + F.wave, (256 - TAIL_C0) * NWAVES, 0, I_TAIL); } PH_END(1, 1)
        PH_BEGIN(2) { pg8::Gemm g{ACT, (const bf16*)(ws + WS_W + (size_t)s * WFFN_B + WGU_B), FF, FF, FF}; pg8::StaticOrder S; S.init(SEQ, DM, 1, F.G, bx);
                   if (s < 7) { pg8::EpiResidStats E{XB, XL, SSQ, DM, 0.5f};
                       pg8::gemm_phase<pg8::EpiResidStats, pg8::StaticOrder, false, true>(F.lds + RING_OFF, g, S, E); }
                   else {
                       pg8::EpiResidFinal E{XB, XL, X, SSQ, IN(22), F.ctl + CW_PANEL, F.ctl + CW_BAR + XB_TMO, DM, 0.5f, EPS};
                       pg8::gemm_phase<pg8::EpiResidFinal, pg8::StaticOrder, false, true>(F.lds + RING_OFF, g, S, E); } } PH_END(2, (s & 1) == 0)
        if (which == 0) {
            if (layer < 2) {
                PH_BEGIN(3) { pg8::Gemm g{XB, (const bf16*)(ws + WS_WA + (size_t)layer * WA_B), DM, DM, DM}; pg8::StaticOrder S; S.init(SEQ, NQKV, 1, F.G, bx);
                           pg8::Unit u0; const int fm256 = S.next(0, u0) ? (u0.pm & ~3) * 256 : 0; fill_rstd_tab(F, SSQ, fm256);
                           pg8::EpiBf16 E{QKV, NQKV, (const LAS float*)(F.lds + TAB_OFF), fm256};
                           pg8::gemm_phase<pg8::EpiBf16, pg8::StaticOrder, true, true>(F.lds + RING_OFF, g, S, E); } PH_END(3, 0)
                PH_BEGIN(4) attn_dilated_phase(F.lds + RING_OFF, QKV, OG, LSE, F.G, bx); PH_END(4, 0)
                PH_BEGIN(5) attn_combine_phase(F, OG, LSE, AO); PH_END(5, 1)
                PH_BEGIN(6) { pg8::Gemm g{AO, (const bf16*)(ws + WS_WA + (size_t)layer * WA_B + 24 * MiB), DM, DM, DM}; pg8::StaticOrder S; S.init(SEQ, DM, 1, F.G, bx);
                           pg8::EpiResidStats E{XB, XL, SSQ, DM, 1.0f};
                           pg8::gemm_phase<pg8::EpiResidStats, pg8::StaticOrder, false, true>(F.lds + RING_OFF, g, S, E); } PH_END(6, 1)
            } else {
                const int jb = layer - 2;
                PH_BEGIN(7) { pg8::Gemm g{XB, (const bf16*)(ws + WS_WB + (size_t)jb * WB_B), DM, DM, DM / 4}; pg8::StaticOrder S; S.init(SEQ, QLR, 4, F.G, bx);
                           pg8::EpiBf16 E{RAW, QLR, nullptr, 0, (size_t)SEQ * QLR};
                           pg8::gemm_phase<pg8::EpiBf16, pg8::StaticOrder, true, true>(F.lds + RING_OFF, g, S, E); } PH_END(7, 1)
                PH_BEGIN(8) latent_post<4, QLR, false>(F, RAW, IN(19) + (size_t)jb * QLR, CB, nullptr, ROPETAB, SSQ); PH_END(8, 1)
                PH_BEGIN(9) { pg8::Gemm g{CB, (const bf16*)(ws + WS_WB + (size_t)jb * WB_B + 2 * MiB), QLR, QLR, QLR}; pg8::StaticOrder S; S.init(SEQ, NQ, 1, F.G, bx);
                           pg8::EpiBf16 E{QKV, NQ, nullptr, 0};
                           pg8::gemm_phase<pg8::EpiBf16, pg8::StaticOrder, true, true>(F.lds + RING_OFF, g, S, E); } PH_END(9, 0)
                PH_BEGIN(11) attn_mla_phase(F.lds + RING_OFF, QKV, KV, KR, AO, (const float*)ROPETAB, F.G, bx); PH_END(11, 0)
                PH_BEGIN(12) { pg8::Gemm g{AO, (const bf16*)(ws + WS_WB + (size_t)jb * WB_B + 8 * MiB), DM, DM, DM}; pg8::StaticOrder S; S.init(SEQ, DM, 1, F.G, bx);
                           pg8::EpiResidStats E{XB, XL, SSQ, DM, 1.0f};
                           pg8::gemm_phase<pg8::EpiResidStats, pg8::StaticOrder, false, true>(F.lds + RING_OFF, g, S, E); } PH_END(12, 1)
            }
        }
    }
#if SEAM_PROBE
    if (bx == 0 && threadIdx.x == 0) { const unsigned ticks = xb_ld(&CTL[8192]) / 256u;
        const unsigned long long t0 = __builtin_amdgcn_s_memrealtime(); while (__builtin_amdgcn_s_memrealtime() - t0 < ticks) __builtin_amdgcn_s_sleep(8); }
#endif
#undef PH_BEGIN
#undef PH_END
}
constexpr int N_PHASES = 1 + 8 * 2 + 2 * 4 + 2 * 5 + 3;

extern "C" void kernel_launch(void* const* d_in, const int* in_sizes, int n_in, void* d_out, int out_size, void* d_ws, size_t ws_size, hipStream_t stream) {
    static int grid = 0;
    if (grid == 0) {
        if (n_in != 23 || in_sizes[0] != SEQ * DM || out_size != SEQ * DM || ws_size < WS_END) {
            fprintf(stderr, "kernel_launch: shape/workspace mismatch: n_in %d in0 %d out %d ws %zu (need %zu); nothing launched\n", n_in, n_in > 0 ? in_sizes[0] : -1, out_size, ws_size, (size_t)WS_END); grid = -1; return; }
        int dev = 0, cus = 0, per_cu = 0;
        if (hipGetDevice(&dev) != hipSuccess || hipDeviceGetAttribute(&cus, hipDeviceAttributeMultiprocessorCount, dev) != hipSuccess) { fprintf(stderr, "kernel_launch: device query failed\n"); grid = -1; return; }
        if (hipFuncSetAttribute((const void*)mk_fwd, hipFuncAttributeMaxDynamicSharedMemorySize, LDS_BYTES) != hipSuccess) { fprintf(stderr, "kernel_launch: hipFuncSetAttribute failed\n"); grid = -1; return; }
        if (hipOccupancyMaxActiveBlocksPerMultiprocessor(&per_cu, (const void*)mk_fwd, NWAVES * 64, LDS_BYTES) != hipSuccess || per_cu < 1)
            fprintf(stderr, "kernel_launch: note: occupancy query reports %d workgroups per CU\n", per_cu);
        (void)hipGetLastError();
        grid = cus;
        if (grid != 256) { fprintf(stderr, "kernel_launch: built for a 256-CU device (one 256x256 unit per workgroup in the residual GEMM phases), found %d CUs; nothing launched\n", grid); grid = -1; return; }
    }
    if (grid < 0) return;
    if (hipMemsetAsync((char*)d_ws + WS_CTL, 0, CTL_ZERO_BYTES, stream) != hipSuccess) { fprintf(stderr, "kernel_launch: memset failed\n"); return; }
    Args a{};
    for (int i = 0; i < 23; ++i) a.in[i] = (const float*)d_in[i];
    a.out = (float*)d_out; a.ws = (unsigned char*)d_ws;
#if MK_PER_PHASE
    for (int p = 0; p < N_PHASES; ++p) { a.ph_lo = p; a.ph_hi = p + 1; hipLaunchKernelGGL(mk_fwd, dim3(grid), dim3(NWAVES * 64), LDS_BYTES, stream, a); }
#else
    a.ph_lo = 0; a.ph_hi = N_PHASES;
    hipLaunchKernelGGL(mk_fwd, dim3(grid), dim3(NWAVES * 64), LDS_BYTES, stream, a);
#endif
    const hipError_t le = hipPeekAtLastError();
    if (le != hipSuccess) fprintf(stderr, "kernel_launch: launch failed: %s\n", hipGetErrorName(le));
}
```

```cpp
#include <hip/hip_runtime.h>
#include <cstdio>
#include <cstdint>

#ifndef MK_PER_PHASE
#define MK_PER_PHASE 0
#endif

#ifndef SEAM_PROBE
#define SEAM_PROBE 0
#define SEAM_MASK 0xffffffffu
#endif
#ifndef PROBE_MASK
#define PROBE_MASK 0u
#endif

namespace pg8 {
#define PG8_LAS __attribute__((address_space(3)))
typedef unsigned short bf16_t;
typedef short bf16x8 __attribute__((ext_vector_type(8)));
typedef float f32x4 __attribute__((ext_vector_type(4)));
typedef float f32x2 __attribute__((ext_vector_type(2)));
typedef unsigned u32x4 __attribute__((ext_vector_type(4)));
constexpr int BM = 256, BK = 64, HALF = 128, HTB = HALF * BK * 2  , STAGE_BYTES = 8 * HTB, NXCD = 8, WGM = 4;

__host__ __device__ __forceinline__ int lds_byte(int r, int c) { const int st = (r >> 4) * 2 + (c >> 5), rr = r & 15, cc = c & 31, ob = rr * 64 + cc * 2; return st * 1024 + (ob ^ (((ob >> 9) & 1) << 5)); }
__host__ __device__ __forceinline__ void stage_rc(int b, int& R, int& C) { const int st = b / 1024, sb = b % 1024, swz = sb ^ (((sb >> 9) & 1) << 5); R = (st >> 1) * 16 + swz / 64; C = (st & 1) * 32 + (swz % 64) / 2; }
__host__ __device__ __forceinline__ int perm32(int rho) { const int n = rho >> 4, i = rho & 15; return 8 * (i >> 2) + 4 * n + (i & 3); }

struct Unit { int pm, pn, ks; };
struct Gemm { const bf16_t* A; const bf16_t* Bt; int lda, ldb, K; };

struct StaticOrder {
    int nM, nN, nS, nwg, G, c;
    __host__ __device__ void init(int M, int N, int nS_, int G_, int c_) { nM = M / BM; nN = N / BM; nS = nS_; nwg = nM * nN * nS; G = G_; c = c_; }
    __host__ __device__ __forceinline__ bool next(int i, Unit& u) const {
        const long L = (long)i * G + c; if (L >= nwg) return false;
        int wgid = (int)L; { const int q = nwg / NXCD, r = nwg % NXCD, xcd = wgid % NXCD, off = wgid / NXCD; wgid = (xcd < r ? xcd * (q + 1) : r * (q + 1) + (xcd - r) * q) + off; }
        const int nNN = nN * nS, nig = WGM * nNN, gid = wgid / nig, fm = gid * WGM, gsz = (nM - fm) < WGM ? (nM - fm) : WGM;
        u.pm = fm + ((wgid % nig) % gsz); const int pq = (wgid % nig) / gsz; u.pn = pq % nN; u.ks = pq / nN; return true;
    }
    __device__ __forceinline__ void a_ready(const Unit&) const {}
    __device__ __forceinline__ void done(const Unit&) const {}
};

__device__ __forceinline__ unsigned cvt_pk_bf16(float lo, float hi) { unsigned r; asm volatile("v_cvt_pk_bf16_f32 %0, %1, %2" : "=v"(r) : "v"(lo), "v"(hi)); return r; }

__device__ __forceinline__ int opaque_tid() { int t; asm volatile("v_mov_b32 %0, %1" : "=v"(t) : "v"(threadIdx.x)); return t; }
struct EpiBf16 {
    static constexpr bool PERM = true, AFTER_DRAIN = false;
    bf16_t* O; int ldc; const PG8_LAS float* tab; int fm256; size_t slice = 0;
    __device__ __forceinline__ void operator()(const f32x4 (&acc)[2][2][4][2], const Unit& u, int wr, int wc, int fr, int fq) const {
        const int row0 = u.pm * BM + wr * 64 + fr, col0 = u.pn * BM + wc * 32 + 8 * fq;
#pragma unroll
        for (int ai = 0; ai < 2; ++ai)
#pragma unroll
            for (int m = 0; m < 4; ++m) { const int row = row0 + ai * HALF + m * 16; bf16_t* rowp = O + (size_t)u.ks * slice + (size_t)row * ldc + col0;
                const float rs = tab ? tab[row - fm256] : 1.0f;
#pragma unroll
                for (int bj = 0; bj < 2; ++bj) { const f32x4 v0 = acc[ai][bj][m][0] * rs, v1 = acc[ai][bj][m][1] * rs;
                    u32x4 w; w.x = cvt_pk_bf16(v0[0], v0[1]); w.y = cvt_pk_bf16(v0[2], v0[3]); w.z = cvt_pk_bf16(v1[0], v1[1]); w.w = cvt_pk_bf16(v1[2], v1[3]);
                    *(u32x4*)(rowp + bj * HALF) = w; } }
    }
};
struct EpiSwiGLU {
    static constexpr bool PERM = true, AFTER_DRAIN = false;
    bf16_t* O; int ldc; const PG8_LAS float* tab; int fm256;
    __device__ __forceinline__ void operator()(const f32x4 (&acc)[2][2][4][2], const Unit& u, int wr, int wc, int fr, int fq) const {
        const int row0 = u.pm * BM + wr * 64 + fr, col0 = u.pn * HALF + wc * 32 + 8 * fq;
#pragma unroll
        for (int ai = 0; ai < 2; ++ai)
#pragma unroll
            for (int m = 0; m < 4; ++m) { const int row = row0 + ai * HALF + m * 16; bf16_t* rowp = O + (size_t)row * ldc + col0;
                const float rs = tab[row - fm256];
                float r[8];
#pragma unroll
                for (int n = 0; n < 2; ++n)
#pragma unroll
                    for (int e = 0; e < 4; ++e) { const float gv = acc[ai][0][m][n][e] * rs, uv = acc[ai][1][m][n][e] * rs;
                        const float sg = gv * __builtin_amdgcn_rcpf(1.0f + __builtin_amdgcn_exp2f(-1.4426950408889634f * gv));
                        r[n * 4 + e] = sg * uv; }
                u32x4 w; w.x = cvt_pk_bf16(r[0], r[1]); w.y = cvt_pk_bf16(r[2], r[3]); w.z = cvt_pk_bf16(r[4], r[5]); w.w = cvt_pk_bf16(r[6], r[7]);
                *(u32x4*)rowp = w; }
    }
};
__device__ __forceinline__ float bf_lo(unsigned u) { return __builtin_bit_cast(float, u << 16); }
__device__ __forceinline__ float bf_hi(unsigned u) { return __builtin_bit_cast(float, u & 0xffff0000u); }
#ifndef RESID_LO
#define RESID_LO 0
#endif
#if RESID_LO
#define RS_LOAD(ai, m0) do { _Pragma("unroll") for (int m = 0; m < 2; ++m) _Pragma("unroll") for (int bj = 0; bj < 2; ++bj) { \
            const size_t off = (size_t)(row0 + (ai) * HALF + ((m0) + m) * 16) * ldc + col0 + bj * HALF; bh[m][bj] = *(const u32x4*)(hi + off); bl[m][bj] = *(const u32x4*)(lo + off); } } while (0)
#define RS_ADD(ai, m0) do { _Pragma("unroll") for (int m = 0; m < 2; ++m) _Pragma("unroll") for (int bj = 0; bj < 2; ++bj) _Pragma("unroll") for (int n = 0; n < 2; ++n) { \
            const unsigned h0 = bh[m][bj][2 * n], h1 = bh[m][bj][2 * n + 1], l0 = bl[m][bj][2 * n], l1 = bl[m][bj][2 * n + 1]; \
            const f32x4 xo = {bf_lo(h0) + bf_lo(l0), bf_hi(h0) + bf_hi(l0), bf_lo(h1) + bf_lo(l1), bf_hi(h1) + bf_hi(l1)}; \
            acc[ai][bj][(m0) + m][n] = xo + acc[ai][bj][(m0) + m][n] * scale; } } while (0)
#else
#define RS_LOADH(B, ai, m0) do { _Pragma("unroll") for (int m = 0; m < 2; ++m) _Pragma("unroll") for (int bj = 0; bj < 2; ++bj) { \
            const size_t off = (size_t)(row0 + (ai) * HALF + ((m0) + m) * 16) * ldc + col0 + bj * HALF; B[m][bj] = *(const u32x4*)(hi + off); } } while (0)
#define RS_ADDH(B, ai, m0) do { _Pragma("unroll") for (int m = 0; m < 2; ++m) _Pragma("unroll") for (int bj = 0; bj < 2; ++bj) _Pragma("unroll") for (int n = 0; n < 2; ++n) { \
            const unsigned h0 = B[m][bj][2 * n], h1 = B[m][bj][2 * n + 1]; \
            const f32x4 xo = {bf_lo(h0), bf_hi(h0), bf_lo(h1), bf_hi(h1)}; \
            acc[ai][bj][(m0) + m][n] = xo + acc[ai][bj][(m0) + m][n] * scale; } } while (0)
#define RS_LOAD(ai, m0) do { if ((m0) == 0) { RS_LOADH(bh, ai, 0); RS_LOADH(bl, ai, 2); } } while (0)
#define RS_ADD(ai, m0) do { if ((m0) == 0) { RS_ADDH(bh, ai, 0); RS_ADDH(bl, ai, 2); } } while (0)
#endif
#define RS_SUMSQ(ai, m, s) do { _Pragma("unroll") for (int bj = 0; bj < 2; ++bj) _Pragma("unroll") for (int n = 0; n < 2; ++n) { const f32x4 v = acc[ai][bj][m][n]; \
            s += (v[0] * v[0] + v[1] * v[1]) + (v[2] * v[2] + v[3] * v[3]); } \
            s += __shfl_xor(s, 16); s += __shfl_xor(s, 32); \
            if (fq == 0) P[((ai) * HALF + wr * 64 + (m) * 16 + fr) * 4 + wc] = s; } while (0)
#define RS_FENCE asm volatile("" ::: "memory")
struct EpiResidStats {
    static constexpr bool PERM = true, AFTER_DRAIN = true;
    bf16_t* hi; bf16_t* lo; float* ssq; int ldc; float scale;
    __device__ __forceinline__ void fused(f32x4 (&acc)[2][2][4][2], const Unit& u, int wr, int wc, int fr, int fq, PG8_LAS unsigned char* lds, int wid, int lane) const {
        PG8_LAS float* P = (PG8_LAS float*)lds;
        const int row0 = u.pm * BM + wr * 64 + fr, col0 = u.pn * BM + wc * 32 + 8 * fq;
        u32x4 bh[2][2], bl[2][2];
#if RESID_LO
#define RS_STORE_LO(h, v0, v1, off) do { u32x4 l; l.x = cvt_pk_bf16(v0[0] - bf_lo(h.x), v0[1] - bf_hi(h.x)); l.y = cvt_pk_bf16(v0[2] - bf_lo(h.y), v0[3] - bf_hi(h.y)); \
                l.z = cvt_pk_bf16(v1[0] - bf_lo(h.z), v1[1] - bf_hi(h.z)); l.w = cvt_pk_bf16(v1[2] - bf_lo(h.w), v1[3] - bf_hi(h.w)); *(u32x4*)(lo + off) = l; } while (0)
#else
#define RS_STORE_LO(h, v0, v1, off) do { } while (0)
#endif
#define RS_STORE(ai, m0) do { _Pragma("unroll") for (int m = (m0); m < (m0) + 2; ++m) { float s = 0.f; \
            _Pragma("unroll") for (int bj = 0; bj < 2; ++bj) { const size_t off = (size_t)(row0 + (ai) * HALF + m * 16) * ldc + col0 + bj * HALF; const f32x4 v0 = acc[ai][bj][m][0], v1 = acc[ai][bj][m][1]; \
                u32x4 h; h.x = cvt_pk_bf16(v0[0], v0[1]); h.y = cvt_pk_bf16(v0[2], v0[3]); h.z = cvt_pk_bf16(v1[0], v1[1]); h.w = cvt_pk_bf16(v1[2], v1[3]); \
                RS_STORE_LO(h, v0, v1, off); *(u32x4*)(hi + off) = h; } \
            RS_SUMSQ(ai, m, s); } } while (0)
#if RESID_LO
        RS_LOAD(0, 0); RS_ADD(0, 0); RS_FENCE;
        RS_LOAD(0, 2); RS_FENCE; RS_STORE(0, 0); RS_ADD(0, 2); RS_FENCE;
        RS_LOAD(1, 0); RS_FENCE; RS_STORE(0, 2); RS_ADD(1, 0); RS_FENCE;
        RS_LOAD(1, 2); RS_FENCE; RS_STORE(1, 0); RS_ADD(1, 2); RS_FENCE;
        RS_STORE(1, 2);
#else
        RS_LOAD(0, 0); RS_ADD(0, 0); RS_FENCE;
        RS_LOAD(1, 0); RS_FENCE; RS_STORE(0, 0); RS_STORE(0, 2); RS_ADD(1, 0); RS_FENCE;
        RS_STORE(1, 0); RS_STORE(1, 2);
#endif
#undef RS_STORE
#undef RS_STORE_LO
        asm volatile("s_waitcnt lgkmcnt(0)" ::: "memory"); __builtin_amdgcn_s_barrier(); asm volatile("" ::: "memory");
        const int t = wid * 64 + lane;
        if (t < 256) { const f32x4 p = *(const PG8_LAS f32x4*)(P + t * 4); ssq[(size_t)(u.pm * BM + t) * 8 + u.pn] = (p[0] + p[1]) + (p[2] + p[3]); }
        asm volatile("s_waitcnt lgkmcnt(0)" ::: "memory"); __builtin_amdgcn_s_barrier(); asm volatile("" ::: "memory");
    }
};
struct EpiResidFinal {
    static constexpr bool PERM = true, AFTER_DRAIN = true;
    const bf16_t* hi; const bf16_t* lo; float* out; float* ssq; const float* gain; unsigned* cnt; unsigned* tmo; int ldc; float scale, eps;
    __device__ __forceinline__ void fused(f32x4 (&acc)[2][2][4][2], const Unit& u, int wr, int wc, int fr, int fq, PG8_LAS unsigned char* lds, int wid, int lane) const {
        PG8_LAS float* P = (PG8_LAS float*)lds;
        const int row0 = u.pm * BM + wr * 64 + fr, col0 = u.pn * BM + wc * 32 + 8 * fq;
        u32x4 bh[2][2], bl[2][2];
#define RS_SSQ(ai, m0) do { _Pragma("unroll") for (int m = (m0); m < (m0) + 2; ++m) { float s = 0.f; RS_SUMSQ(ai, m, s); } } while (0)
#if RESID_LO
        RS_LOAD(0, 0); RS_ADD(0, 0); RS_FENCE;
        RS_LOAD(0, 2); RS_FENCE; RS_SSQ(0, 0); RS_ADD(0, 2); RS_FENCE;
        RS_LOAD(1, 0); RS_FENCE; RS_SSQ(0, 2); RS_ADD(1, 0); RS_FENCE;
        RS_LOAD(1, 2); RS_FENCE; RS_SSQ(1, 0); RS_ADD(1, 2); RS_FENCE;
        RS_SSQ(1, 2);
#else
        RS_LOAD(0, 0); RS_ADD(0, 0); RS_FENCE;
        RS_LOAD(1, 0); RS_FENCE; RS_SSQ(0, 0); RS_SSQ(0, 2); RS_ADD(1, 0); RS_FENCE;
        RS_SSQ(1, 0); RS_SSQ(1, 2);
#endif
#undef RS_SSQ
        asm volatile("s_waitcnt lgkmcnt(0)" ::: "memory"); __builtin_amdgcn_s_barrier(); asm volatile("" ::: "memory");
        const int t = wid * 64 + lane;
        if (t < 256) { const f32x4 p = *(const PG8_LAS f32x4*)(P + t * 4); ssq[(size_t)(u.pm * BM + t) * 8 + u.pn] = (p[0] + p[1]) + (p[2] + p[3]); }
        asm volatile("s_waitcnt vmcnt(0) lgkmcnt(0)" ::: "memory"); __syncthreads();
        if (t == 0) {
            __builtin_amdgcn_fence(__ATOMIC_RELEASE, "agent"); asm volatile("s_waitcnt vmcnt(0)" ::: "memory");
            (void)__hip_atomic_fetch_add(cnt + 16 * u.pm, 1u, __ATOMIC_RELAXED, __HIP_MEMORY_SCOPE_AGENT);
            unsigned sp = 0u;
            while (__hip_atomic_load(cnt + 16 * u.pm, __ATOMIC_RELAXED, __HIP_MEMORY_SCOPE_AGENT) < 8u) { __builtin_amdgcn_s_sleep(1);
                if ((++sp & 255u) == 0u) { if (__hip_atomic_load(tmo, __ATOMIC_RELAXED, __HIP_MEMORY_SCOPE_AGENT)) break; if (sp > (1u << 18)) { atomicAdd(tmo, 1u); break; } } }
            __builtin_amdgcn_fence(__ATOMIC_ACQUIRE, "agent"); asm volatile("s_waitcnt vmcnt(0)" ::: "memory");
        }
        __syncthreads();
        f32x4 g[2][2];
#pragma unroll
        for (int bj = 0; bj < 2; ++bj)
#pragma unroll
            for (int n = 0; n < 2; ++n) g[bj][n] = *(const f32x4*)(gain + col0 + bj * HALF + n * 4);
#pragma unroll
        for (int ai = 0; ai < 2; ++ai)
#pragma unroll
            for (int m = 0; m < 4; ++m) { const int row = row0 + ai * HALF + m * 16;
                const f32x4 s0 = *(const f32x4*)(ssq + (size_t)row * 8), s1 = *(const f32x4*)(ssq + (size_t)row * 8 + 4);
                const float s = ((s0[0] + s0[1]) + (s0[2] + s0[3])) + ((s1[0] + s1[1]) + (s1[2] + s1[3]));
                const float rstd = 1.0f / sqrtf(s * (1.0f / 2048.0f) + eps);
                const size_t off = (size_t)row * ldc + col0;
#pragma unroll
                for (int bj = 0; bj < 2; ++bj)
#pragma unroll
                    for (int n = 0; n < 2; ++n) __builtin_nontemporal_store(acc[ai][bj][m][n] * rstd * g[bj][n], (f32x4*)(out + off + bj * HALF + n * 4)); }
    }
};
#undef RS_FENCE
#undef RS_LOAD
#undef RS_ADD
#undef RS_SUMSQ
#if !RESID_LO
#undef RS_LOADH
#undef RS_ADDH
#endif
struct EpiF32 {
    static constexpr bool PERM = false, AFTER_DRAIN = false;
    float* O; int ldc; size_t slice;
    __device__ __forceinline__ void operator()(const f32x4 (&acc)[2][2][4][2], const Unit& u, int wr, int wc, int fr, int fq) const {
        const int row0 = u.pm * BM + wr * 64 + fr, col0 = u.pn * BM + wc * 32 + 4 * fq; float* Ob = O + (size_t)u.ks * slice;
#pragma unroll
        for (int ai = 0; ai < 2; ++ai)
#pragma unroll
            for (int m = 0; m < 4; ++m) { const size_t off = (size_t)(row0 + ai * HALF + m * 16) * ldc + col0;
#pragma unroll
                for (int bj = 0; bj < 2; ++bj)
#pragma unroll
                    for (int n = 0; n < 2; ++n) *(f32x4*)(Ob + off + bj * HALF + n * 16) = acc[ai][bj][m][n];
            }
    }
};

template <class Epi, class Sched, bool ALIGN_EPI = false, bool SP2 = false>
__device__ __forceinline__ void gemm_phase(PG8_LAS unsigned char* lds, const Gemm g, const Sched& S, const Epi& E) {
    const int tid = opaque_tid(), wid = __builtin_amdgcn_readfirstlane(tid >> 6), lane = tid & 63, wr = wid >> 2, wc = wid & 3, fr = lane & 15, fq = lane >> 4;
    const int K = g.K, nt = K / BK;
#define PG8_UA(u) ((const char*)g.A + ((size_t)(u).pm * BM * g.lda + (size_t)(u).ks * K) * 2)
#define PG8_UB(u) ((const char*)g.Bt + ((size_t)(u).pn * BM * g.ldb + (size_t)(u).ks * K) * 2)
    unsigned voffA[2], voffB[2];
#pragma unroll
    for (int i = 0; i < 2; ++i) { int R, C; stage_rc(tid * 16 + i * 8192, R, C); const int Rb = Epi::PERM ? ((R & ~31) + perm32(R & 31)) : R;
        voffA[i] = (unsigned)(R * g.lda + C) * 2u; voffB[i] = (unsigned)(Rb * g.ldb + C) * 2u; }
    const size_t kstep = (size_t)(BK * 2);
    const size_t hstepA = (size_t)HALF * g.lda * 2, hstepB = (size_t)HALF * g.ldb * 2;
    const unsigned ldsw = (unsigned)wid * 1024u;
    const int aoff = lds_byte(wr * 64 + fr, fq * 8), boff = lds_byte(wc * 32 + fr, fq * 8);
#define PG8_SA(b, h) (((b) * 2 + (h)) * HTB)
#define PG8_SB(b, h) ((4 + (b) * 2 + (h)) * HTB)
#define PG8_STAGE(bufoff, gbase, voff) do { _Pragma("unroll") for (int _i = 0; _i < 2; ++_i) \
        __builtin_amdgcn_global_load_lds((const unsigned*)((const char*)(gbase) + (voff)[_i]), (PG8_LAS unsigned*)(lds + (bufoff) + ldsw + _i * 8192), 16, 0, 0); } while (0)
#define PG8_LDA(dst, b, h) do { _Pragma("unroll") for (int m = 0; m < 4; ++m) _Pragma("unroll") for (int k = 0; k < 2; ++k) dst[m][k] = *(const PG8_LAS bf16x8*)(lds + PG8_SA(b, h) + aoff + m * 2048 + k * 1024); } while (0)
#define PG8_LDB(dst, b, h) do { _Pragma("unroll") for (int n = 0; n < 2; ++n) _Pragma("unroll") for (int k = 0; k < 2; ++k) dst[n][k] = *(const PG8_LAS bf16x8*)(lds + PG8_SB(b, h) + boff + n * 2048 + k * 1024); } while (0)
#define PG8_MMA(ai, bj, At, Bt) do { __builtin_amdgcn_s_setprio(1); _Pragma("unroll") for (int m = 0; m < 4; ++m) _Pragma("unroll") for (int n = 0; n < 2; ++n) _Pragma("unroll") for (int k = 0; k < 2; ++k) \
        acc[ai][bj][m][n] = __builtin_amdgcn_mfma_f32_16x16x32_bf16(Bt[n][k], At[m][k], acc[ai][bj][m][n], 0, 0, 0); __builtin_amdgcn_s_setprio(0); } while (0)
#define PG8_WAIT_V(n) asm volatile("s_waitcnt vmcnt(" #n ")" ::: "memory")
#define PG8_WAIT_L(n) asm volatile("s_waitcnt lgkmcnt(" #n ")" ::: "memory")
#define PG8_BAR __builtin_amdgcn_s_barrier()
#define PG8_SCHED __builtin_amdgcn_sched_barrier(0)
    Unit cur, nxt; int ui = 0;
    if (!S.next(0, cur)) return;
    f32x4 acc[2][2][4][2];
#pragma unroll
    for (int a = 0; a < 2; ++a)
#pragma unroll
        for (int b = 0; b < 2; ++b)
#pragma unroll
            for (int m = 0; m < 4; ++m)
#pragma unroll
                for (int n = 0; n < 2; ++n) acc[a][b][m][n] = (f32x4){0.f, 0.f, 0.f, 0.f};
    bf16x8 At[4][2], B0[2][2], B1[2][2];
    const char* cA = PG8_UA(cur); const char* cB = PG8_UB(cur);
    S.a_ready(cur);
    if constexpr (SP2) {
        PG8_STAGE(PG8_SB(0, 0), cB, voffB); PG8_STAGE(PG8_SB(0, 1), cB + hstepB, voffB); PG8_STAGE(PG8_SA(0, 0), cA, voffA); PG8_STAGE(PG8_SA(0, 1), cA + hstepA, voffA);
        if (wr == 1) PG8_BAR;
        PG8_WAIT_V(2); PG8_BAR;
        PG8_STAGE(PG8_SB(1, 0), cB + kstep, voffB); PG8_STAGE(PG8_SA(1, 0), cA + kstep, voffA); PG8_STAGE(PG8_SB(1, 1), cB + hstepB + kstep, voffB);
        PG8_WAIT_V(6); PG8_BAR;
    } else {
        PG8_STAGE(PG8_SB(0, 0), cB, voffB); PG8_STAGE(PG8_SA(0, 0), cA, voffA); PG8_STAGE(PG8_SB(0, 1), cB + hstepB, voffB); PG8_STAGE(PG8_SA(0, 1), cA + hstepA, voffA);
        if (wr == 1) PG8_BAR;
        PG8_WAIT_V(4); PG8_BAR;
        PG8_STAGE(PG8_SB(1, 0), cB + kstep, voffB); PG8_STAGE(PG8_SA(1, 0), cA + kstep, voffA); PG8_STAGE(PG8_SB(1, 1), cB + hstepB + kstep, voffB);
        PG8_WAIT_V(6); PG8_BAR;
    }
    for (;;) {
        const bool has_next = S.next(ui + 1, nxt);
        const char* nA = has_next ? PG8_UA(nxt) : cA; const char* nB = has_next ? PG8_UB(nxt) : cB;
        for (int t = 0; t < nt; t += 2) {
            const bool last = (t == nt - 2);
            const char* a1 = cA + (size_t)(t + 1) * kstep;
            const char* a2 = last ? nA : cA + (size_t)(t + 2) * kstep; const char* b2 = last ? nB : cB + (size_t)(t + 2) * kstep;
            const char* a3 = a2 + kstep; const char* b3 = b2 + kstep;
            if (last && has_next) S.a_ready(nxt);
            if constexpr (SP2) {
            PG8_LDB(B0, 0, 0); PG8_LDB(B1, 0, 1); PG8_SCHED; PG8_LDA(At, 0, 0); PG8_STAGE(PG8_SA(1, 1), a1 + hstepA, voffA);
            PG8_WAIT_V(8); PG8_WAIT_L(0); PG8_BAR; PG8_MMA(0, 0, At, B0); PG8_MMA(0, 1, At, B1); PG8_BAR; PG8_SCHED;
            PG8_LDA(At, 0, 1); PG8_STAGE(PG8_SB(0, 0), b2, voffB); PG8_STAGE(PG8_SB(0, 1), b2 + hstepB, voffB); PG8_STAGE(PG8_SA(0, 0), a2, voffA);
            PG8_WAIT_V(8); PG8_WAIT_L(0); PG8_BAR; PG8_MMA(1, 0, At, B0); PG8_MMA(1, 1, At, B1); PG8_BAR; PG8_SCHED;
            PG8_LDB(B0, 1, 0); PG8_LDB(B1, 1, 1); PG8_SCHED; PG8_LDA(At, 1, 0); PG8_STAGE(PG8_SA(0, 1), a2 + hstepA, voffA);
            PG8_WAIT_V(8); PG8_WAIT_L(0); PG8_BAR; PG8_MMA(0, 0, At, B0); PG8_MMA(0, 1, At, B1); PG8_BAR; PG8_SCHED;
            PG8_LDA(At, 1, 1); PG8_STAGE(PG8_SB(1, 0), b3, voffB); PG8_STAGE(PG8_SB(1, 1), b3 + hstepB, voffB); PG8_STAGE(PG8_SA(1, 0), a3, voffA);
            PG8_WAIT_V(8); PG8_WAIT_L(0); PG8_BAR; PG8_MMA(1, 0, At, B0); PG8_MMA(1, 1, At, B1); PG8_BAR; PG8_SCHED;
            } else {
            PG8_LDB(B0, 0, 0); PG8_SCHED; PG8_LDA(At, 0, 0); PG8_STAGE(PG8_SA(1, 1), a1 + hstepA, voffA);
            PG8_WAIT_L(8); PG8_BAR; PG8_WAIT_L(0); PG8_MMA(0, 0, At, B0); PG8_BAR; PG8_SCHED;
            PG8_LDB(B1, 0, 1); PG8_STAGE(PG8_SB(0, 0), b2, voffB);
            PG8_BAR; PG8_WAIT_L(0); PG8_MMA(0, 1, At, B1); PG8_BAR;
            PG8_LDA(At, 0, 1); PG8_STAGE(PG8_SA(0, 0), a2, voffA);
            PG8_BAR; PG8_WAIT_L(0); PG8_MMA(1, 0, At, B0); PG8_BAR; PG8_SCHED;
            PG8_STAGE(PG8_SB(0, 1), b2 + hstepB, voffB);
            PG8_WAIT_V(6); PG8_BAR; PG8_MMA(1, 1, At, B1); PG8_BAR;
            PG8_LDB(B0, 1, 0); PG8_SCHED; PG8_LDA(At, 1, 0); PG8_STAGE(PG8_SA(0, 1), a2 + hstepA, voffA);
            PG8_WAIT_L(8); PG8_BAR; PG8_WAIT_L(0); PG8_MMA(0, 0, At, B0); PG8_BAR; PG8_SCHED;
            PG8_LDB(B1, 1, 1); PG8_STAGE(PG8_SB(1, 0), b3, voffB);
            PG8_BAR; PG8_WAIT_L(0); PG8_MMA(0, 1, At, B1); PG8_BAR;
            PG8_LDA(At, 1, 1); PG8_STAGE(PG8_SA(1, 0), a3, voffA);
            PG8_BAR; PG8_WAIT_L(0); PG8_MMA(1, 0, At, B0); PG8_BAR; PG8_SCHED;
            PG8_STAGE(PG8_SB(1, 1), b3 + hstepB, voffB);
            PG8_WAIT_V(6); PG8_BAR; PG8_MMA(1, 1, At, B1); PG8_BAR;
            }
        }
        if constexpr (ALIGN_EPI) { if (wr == 0) PG8_BAR; }
        if constexpr (!Epi::AFTER_DRAIN) { E(acc, cur, wr, wc, fr, fq); S.done(cur); }
        if (!has_next) break;
#pragma unroll
        for (int a = 0; a < 2; ++a)
#pragma unroll
            for (int b = 0; b < 2; ++b)
#pragma unroll
                for (int m = 0; m < 4; ++m)
#pragma unroll
                    for (int n = 0; n < 2; ++n) acc[a][b][m][n] = (f32x4){0.f, 0.f, 0.f, 0.f};
        cur = nxt; cA = nA; cB = nB; ++ui;
        if constexpr (ALIGN_EPI) { if (wr == 1) PG8_BAR; }
    }
    PG8_WAIT_V(0);
    if constexpr (!ALIGN_EPI) { if (wr == 0) PG8_BAR; }
    PG8_BAR;
    if constexpr (Epi::AFTER_DRAIN) { E.fused(acc, cur, wr, wc, fr, fq, lds, wid, lane); S.done(cur); }
#undef PG8_UA
#undef PG8_UB
#undef PG8_SA
#undef PG8_SB
#undef PG8_STAGE
#undef PG8_LDA
#undef PG8_LDB
#undef PG8_MMA
#undef PG8_WAIT_V
#undef PG8_WAIT_L
#undef PG8_BAR
#undef PG8_SCHED
}
}

#define LAS __attribute__((address_space(3)))
#define GAS __attribute__((address_space(1)))
#define XB_TMO      128
#define XB_XCNT(j)  (256  + 64 * (j))
#define XB_XSUB(j)  (1280 + 64 * (j))
#define XB_XGEN(j)  (2304 + 64 * (j))
#define XB_TOP      3328
#define XB_TOPGEN   3392
#define XCD_BAR_WORDS 3456
#define XB_LSUB(j)  (6144 + 64 * (j))
#define XB_LGEN(j)  (8192 + 64 * (j))
#define XB_SPIN_CAP (1u << 18)
#ifndef EARLY_INV
#define EARLY_INV 1
#endif
#ifndef TOP_POLL
#define TOP_POLL 1
#endif

__device__ __forceinline__ unsigned xb_ld(unsigned* p)              { return __hip_atomic_load(p, __ATOMIC_RELAXED, __HIP_MEMORY_SCOPE_AGENT); }
__device__ __forceinline__ unsigned xb_add(unsigned* p, unsigned v) { return __hip_atomic_fetch_add(p, v, __ATOMIC_RELAXED, __HIP_MEMORY_SCOPE_AGENT); }
__device__ __forceinline__ unsigned xb_xcc_id() { return (unsigned)__builtin_amdgcn_s_getreg((3 << 11) | 20) & 0xFu; }
#define XB_SPIN(cond, bar) do { unsigned _sp = 0; while (cond) { __builtin_amdgcn_s_sleep(1); \
    if ((++_sp & 255u) == 0u) { if (xb_ld(&(bar)[XB_TMO])) break; if (_sp > XB_SPIN_CAP) { atomicAdd(&(bar)[XB_TMO], 1u); break; } } } } while (0)

struct XcdBarrier {
    unsigned* bar; unsigned x;
    volatile LAS unsigned* st;
#if SEAM_PROBE
    unsigned probe;
#endif
};

__device__ __forceinline__ XcdBarrier xcd_barrier_post(unsigned* bar, volatile LAS unsigned* st) {
    XcdBarrier b; b.bar = bar; b.x = xb_xcc_id(); b.st = st;
    if (threadIdx.x == 0) st[2] = xb_add(&bar[XB_XCNT(b.x)], 1u);
    return b;
}
__device__ __forceinline__ void xcd_barrier_complete(unsigned* bar, unsigned x, unsigned& nloc, unsigned& nx) {
    const unsigned G = gridDim.x * gridDim.y * gridDim.z;
    unsigned sum, cnt, mine, sp = 0u;
    for (;;) {
        sum = 0u; cnt = 0u; mine = 0u;
#pragma unroll
        for (unsigned j = 0; j < 16; ++j) { const unsigned c = xb_ld(&bar[XB_XCNT(j)]); sum += c; cnt += (c > 0u) ? 1u : 0u; mine = (j == x) ? c : mine; }
        if (sum == G) break;
        __builtin_amdgcn_s_sleep(1);
        if ((++sp & 255u) == 0u) { if (xb_ld(&bar[XB_TMO])) break; if (sp > XB_SPIN_CAP) { atomicAdd(&bar[XB_TMO], 1u); break; } }
    }
    nloc = mine > 0u ? mine : 1u; nx = cnt > 0u ? cnt : 1u;
}

__device__ __forceinline__ void xcd_barrier(const XcdBarrier& b) {
    asm volatile("s_waitcnt vmcnt(0)" ::: "memory");
    __syncthreads();
    if (threadIdx.x == 0) {
        unsigned* bar = b.bar;
#if SEAM_PROBE
        const unsigned seam_t0 = (unsigned)__builtin_amdgcn_s_memrealtime();
#endif
        __builtin_amdgcn_s_waitcnt(0);
        unsigned nloc = b.st[0], nx = b.st[1];
        if (nloc == 0u) { xcd_barrier_complete(bar, b.x, nloc, nx); b.st[0] = nloc; b.st[1] = nx;
            unsigned ok = (nx == 8u && gridDim.x == 256u) ? 1u : 0u;
#pragma unroll
            for (unsigned j = 0; j < 16; ++j) { const unsigned c = xb_ld(&bar[XB_XCNT(j)]); if (c != 0u && c != 32u) ok = 0u; }
            if (b.x >= 8u || b.st[2] >= 32u) ok = 0u;
            b.st[3] = ok; b.st[4] = ok ? (b.st[2] * 8u + b.x) : blockIdx.x; }
        const unsigned old = xb_add(&bar[XB_XSUB(b.x)], 1u);
        const unsigned gen = old / nloc;
        if (old + 1u == (gen + 1u) * nloc) {
#if SEAM_PROBE == 2
            const unsigned fence_t0 = (unsigned)__builtin_amdgcn_s_memrealtime();
#endif
            __builtin_amdgcn_fence(__ATOMIC_RELEASE, "agent");
            asm volatile("s_waitcnt vmcnt(0)" ::: "memory");
#if SEAM_PROBE == 2
            if (b.probe) atomicAdd(&bar[8192 - 4096], ((unsigned)__builtin_amdgcn_s_memrealtime() - fence_t0) * 32u);
#endif
#if SEAM_PROBE == 3
            const unsigned top_t0 = (unsigned)__builtin_amdgcn_s_memrealtime();
#endif
#if TOP_POLL
            (void)xb_add(&bar[XB_TOP], 1u);
            const unsigned target = (gen + 1u) * nx;
            XB_SPIN(xb_ld(&bar[XB_TOP]) < target, bar);
#else
            const unsigned og = xb_add(&bar[XB_TOP], 1u);
            const unsigned tg = og / nx;
            if (og + 1u == (tg + 1u) * nx) xb_add(&bar[XB_TOPGEN], 1u);
            else XB_SPIN(xb_ld(&bar[XB_TOPGEN]) == tg, bar);
#endif
#if SEAM_PROBE == 3
            if (b.probe) atomicAdd(&bar[8192 - 4096], ((unsigned)__builtin_amdgcn_s_memrealtime() - top_t0) * 32u);
#endif
            __builtin_amdgcn_fence(__ATOMIC_ACQUIRE, "agent");
            xb_add(&bar[XB_XGEN(b.x)], 1u);
            asm volatile("s_waitcnt vmcnt(0)" ::: "memory");
        } else {
#if EARLY_INV
            asm volatile("buffer_inv sc1" ::: "memory");
            XB_SPIN(xb_ld(&bar[XB_XGEN(b.x)]) == gen, bar);
            asm volatile("s_waitcnt vmcnt(0)" ::: "memory");
#else
            XB_SPIN(xb_ld(&bar[XB_XGEN(b.x)]) == gen, bar);
            __builtin_amdgcn_fence(__ATOMIC_ACQUIRE, "agent");
            asm volatile("s_waitcnt vmcnt(0)" ::: "memory");
#endif
        }
#if SEAM_PROBE == 1
        if (b.probe) atomicAdd(&bar[8192 - 4096], (unsigned)__builtin_amdgcn_s_memrealtime() - seam_t0);
#endif
    }
    __syncthreads();
}

__device__ __forceinline__ void xcd_local_barrier(const XcdBarrier& b) {
    asm volatile("s_waitcnt vmcnt(0)" ::: "memory");
    __syncthreads();
    if (threadIdx.x == 0) {
        unsigned* bar = b.bar;
        __builtin_amdgcn_s_waitcnt(0);
        const unsigned j = b.x * 4u + (b.st[2] & 3u);
        const unsigned old = xb_add(&bar[XB_LSUB(j)], 1u);
        asm volatile("buffer_inv sc1" ::: "memory");
        const unsigned gen = old >> 3;
        if (old + 1u == (gen + 1u) * 8u) (void)xb_add(&bar[XB_LGEN(j)], 1u);
        else XB_SPIN(xb_ld(&bar[XB_LGEN(j)]) == gen, bar);
        asm volatile("s_waitcnt vmcnt(0)" ::: "memory");
    }
    __syncthreads();
}

namespace fa {
typedef short bf16x8 __attribute__((ext_vector_type(8)));
typedef short s16x4 __attribute__((ext_vector_type(4)));
typedef float f32x16 __attribute__((ext_vector_type(16)));
typedef unsigned short bf16;
constexpr int SHM_V = 16384;
constexpr int V_OFF = 0;
constexpr int K_OFF = 2 * SHM_V;
constexpr int SCR_OFF = K_OFF + 2 * 24576;
constexpr float THR = 8.f;

__device__ __forceinline__ int v_rd_base(int lane) { return ((lane & 3) << 3) | (((lane >> 2) & 3) << 6) | (((lane >> 4) & 1) << 5) | (((lane >> 5) & 1) << 8); }
constexpr int v_rd_off(int d0, int ks, int half) { return d0 * 512 + ks * 4096 + half * 2048; }
__device__ __forceinline__ int crow(int r, int hi) { return (r & 3) + 8 * (r >> 2) + 4 * hi; }
__device__ __forceinline__ unsigned cvtpk(float lo, float hi) { unsigned r; asm volatile("v_cvt_pk_bf16_f32 %0, %1, %2" : "=v"(r) : "v"(lo), "v"(hi)); return r; }

template <int DQK>
__device__ __forceinline__ void qkt(f32x16& p0, f32x16& p1, const LAS unsigned char* kbuf, int r32, int hi, const bf16x8* qr) {
    p0 = f32x16{}; p1 = f32x16{};
    __builtin_amdgcn_s_setprio(1);
    if constexpr (DQK == 192) {
        const int x = (r32 >> 1) & 7; const LAS unsigned char* kb[4];
#pragma unroll
        for (int e = 0; e < 4; ++e) kb[e] = kbuf + r32 * 384 + (((2 * e + hi) ^ x) << 4);
#pragma unroll
        for (int d0 = 0; d0 < 12; ++d0) { const LAS unsigned char* a = kb[d0 & 3] + (d0 >> 2) * 128;
            const bf16x8 b0 = *(const LAS bf16x8*)a, b1 = *(const LAS bf16x8*)(a + 32 * 384);
            p0 = __builtin_amdgcn_mfma_f32_32x32x16_bf16(b0, qr[d0], p0, 0, 0, 0);
            p1 = __builtin_amdgcn_mfma_f32_32x32x16_bf16(b1, qr[d0], p1, 0, 0, 0); }
    } else {
        const int x = r32 & 7; const LAS unsigned char* kb[4];
#pragma unroll
        for (int e = 0; e < 4; ++e) kb[e] = kbuf + r32 * 256 + (((2 * e + hi) ^ x) << 4);
#pragma unroll
        for (int d0 = 0; d0 < 8; ++d0) { const LAS unsigned char* a = kb[d0 & 3] + (d0 >> 2) * 128;
            const bf16x8 b0 = *(const LAS bf16x8*)a, b1 = *(const LAS bf16x8*)(a + 32 * 256);
            p0 = __builtin_amdgcn_mfma_f32_32x32x16_bf16(b0, qr[d0], p0, 0, 0, 0);
            p1 = __builtin_amdgcn_mfma_f32_32x32x16_bf16(b1, qr[d0], p1, 0, 0, 0); }
    }
    __builtin_amdgcn_s_setprio(0);
}
__device__ __forceinline__ void pv_tile(f32x16* o, unsigned vb0, bf16x8 pa0, bf16x8 pa1, bf16x8 pa2, bf16x8 pa3) {
#define TRRD(dst, off) asm volatile("ds_read_b64_tr_b16 %0, %1 offset:%2" : "=&v"(dst) : "v"(vb0), "i"(off) : "memory")
#define PV_D0(d0) do { s16x4 l0, l1, l2, l3, h0, h1, h2, h3; constexpr int b_ = v_rd_off(d0, 0, 0); \
        TRRD(l0, b_); TRRD(h0, b_ + 2048); TRRD(l1, b_ + 4096); TRRD(h1, b_ + 6144); TRRD(l2, b_ + 8192); TRRD(h2, b_ + 10240); TRRD(l3, b_ + 12288); TRRD(h3, b_ + 14336); \
        asm volatile("s_waitcnt lgkmcnt(0)" ::: "memory"); __builtin_amdgcn_sched_barrier(0); \
        o[d0] = __builtin_amdgcn_mfma_f32_32x32x16_bf16(pa0, (bf16x8){l0[0], l0[1], l0[2], l0[3], h0[0], h0[1], h0[2], h0[3]}, o[d0], 0, 0, 0);   \
        o[d0] = __builtin_amdgcn_mfma_f32_32x32x16_bf16(pa1, (bf16x8){l1[0], l1[1], l1[2], l1[3], h1[0], h1[1], h1[2], h1[3]}, o[d0], 0, 0, 0);   \
        o[d0] = __builtin_amdgcn_mfma_f32_32x32x16_bf16(pa2, (bf16x8){l2[0], l2[1], l2[2], l2[3], h2[0], h2[1], h2[2], h2[3]}, o[d0], 0, 0, 0);   \
        o[d0] = __builtin_amdgcn_mfma_f32_32x32x16_bf16(pa3, (bf16x8){l3[0], l3[1], l3[2], l3[3], h3[0], h3[1], h3[2], h3[3]}, o[d0], 0, 0, 0); } while (0)
    __builtin_amdgcn_s_setprio(1);
    PV_D0(0); PV_D0(1); PV_D0(2); PV_D0(3);
    __builtin_amdgcn_s_setprio(0);
#undef PV_D0
#undef TRRD
}

struct UnitArgs {
    const bf16* Q; size_t qs;
    const bf16* K; size_t ks;
    const bf16* Kr; size_t krs;
    const bf16* V; size_t vs;
    bf16* O; size_t os;
    float* lse; size_t ls;
    int q0;
    int W;
    float scale;
    float bias;
    int rev;
    const float* rope;
};

template <int DQK, bool ALIBI>
__device__ __forceinline__ void attn_unit(LAS unsigned char* lds, const UnitArgs& u) {
    constexpr int KROW = DQK * 2, SHM_K = 64 * KROW, NKP = SHM_K / 8192, CPR = DQK / 8;
    const int tid = pg8::opaque_tid(), wid = __builtin_amdgcn_readfirstlane(tid >> 6), lane = tid & 63, r32 = lane & 31, hi = lane >> 5;
    const int W = u.W, q0 = u.q0;
    const int lowk = q0 - W + 1, j_lo = lowk > 0 ? lowk / 64 : 0, j_hi = (q0 + 255) / 64 + 1, NT = j_hi - j_lo;
    const int qlo = q0 + wid * 32;
    const float C2 = 1.4426950408889634f * u.scale;
    bf16x8 qr[DQK / 16];
    { const bf16* qp = u.Q + (size_t)(qlo + r32) * u.qs + hi * 8;
#pragma unroll
      for (int d0 = 0; d0 < DQK / 16; ++d0) qr[d0] = *(const bf16x8*)(qp + d0 * 16); }
    if constexpr (DQK == 192) { if (u.rope) {
#pragma unroll
        for (int d0 = 8; d0 < 10; ++d0) { const pg8::f32x4* tp = (const pg8::f32x4*)(u.rope + ((size_t)(qlo + r32) * 32 + 16 * (d0 - 8) + 8 * hi) * 2);
            pg8::f32x4 cs[4];
#pragma unroll
            for (int k = 0; k < 4; ++k) cs[k] = tp[k];
            bf16x8 a = qr[d0], b = qr[d0 + 2];
#pragma unroll
            for (int e = 0; e < 8; e += 2) { const pg8::f32x4 c = cs[e >> 1];
                const float a0 = __builtin_bit_cast(float, (unsigned)(unsigned short)a[e] << 16), a1 = __builtin_bit_cast(float, (unsigned)(unsigned short)a[e + 1] << 16);
                const float b0 = __builtin_bit_cast(float, (unsigned)(unsigned short)b[e] << 16), b1 = __builtin_bit_cast(float, (unsigned)(unsigned short)b[e + 1] << 16);
                const unsigned na = cvtpk(a0 * c[0] - b0 * c[1], a1 * c[2] - b1 * c[3]), nb = cvtpk(a0 * c[1] + b0 * c[0], a1 * c[3] + b1 * c[2]);
                a[e] = (short)(na & 0xffffu); a[e + 1] = (short)(na >> 16); b[e] = (short)(nb & 0xffffu); b[e + 1] = (short)(nb >> 16); }
            qr[d0] = a; qr[d0 + 2] = b; } } }
    const char* ksrc[NKP]; long kstep[NKP]; const char* vsrc[2];
    const int jt0 = u.rev ? (j_lo + NT - 1) : j_lo;
    const long dirn = u.rev ? -1 : 1;
#pragma unroll
    for (int i = 0; i < NKP; ++i) { const int L = (wid * NKP + i) * 64 + lane, row = L / CPR, cs = L % CPR;
        const int chunk = (DQK == 192) ? (cs ^ ((row >> 1) & 7)) : (cs ^ (row & 7));
        if (DQK == 192 && chunk >= 16) { ksrc[i] = (const char*)(u.Kr + (size_t)(jt0 * 64 + row) * u.krs + (chunk - 16) * 8); kstep[i] = dirn * (long)(64 * u.krs * 2); }
        else { ksrc[i] = (const char*)(u.K + (size_t)(jt0 * 64 + row) * u.ks + chunk * 8); kstep[i] = dirn * (long)(64 * u.ks * 2); } }
#pragma unroll
    for (int i = 0; i < 2; ++i) { const int L = (wid * 2 + i) * 64 + lane, sub = L >> 5, rem = L & 31, kk = (sub >> 2) * 8 + (rem >> 2);
        const int k = kk, c = (sub & 3) * 32 + (rem & 3) * 8;
        vsrc[i] = (const char*)(u.V + (size_t)(jt0 * 64 + k) * u.vs + c); }
    const long vstep = dirn * (long)(64 * u.vs * 2);
#define FA_ISSUE(buf) do { \
        _Pragma("unroll") for (int i_ = 0; i_ < NKP; ++i_) { __builtin_amdgcn_global_load_lds((const unsigned*)ksrc[i_], (LAS unsigned*)(lds + K_OFF + (buf) * SHM_K + (wid * NKP + i_) * 1024), 16, 0, 0); ksrc[i_] += kstep[i_]; } \
        _Pragma("unroll") for (int i_ = 0; i_ < 2; ++i_) { __builtin_amdgcn_global_load_lds((const unsigned*)vsrc[i_], (LAS unsigned*)(lds + V_OFF + (buf) * SHM_V + (wid * 2 + i_) * 1024), 16, 0, 0); vsrc[i_] += vstep; } } while (0)
    LAS float* scr = (LAS float*)(lds + SCR_OFF) + wid * 64; LAS float* li_l = scr; LAS float* al_l = scr + 32;
    const unsigned vbase = (unsigned)(size_t)(lds + V_OFF) + (unsigned)v_rd_base(lane);
    float m_reg = -1e30f, l_reg = 0.f; f32x16 o[4] = {};
    FA_ISSUE(0);
    for (int t = 0; t < NT; ++t) {
        asm volatile("s_waitcnt vmcnt(0)" ::: "memory"); __builtin_amdgcn_s_barrier(); asm volatile("" ::: "memory");
        const int b = t & 1;
        const int kb = (u.rev ? (j_lo + NT - 1 - t) : (j_lo + t)) * 64;
        const bool act = (kb <= qlo + 31) && (kb + 63 >= qlo - W + 1);
        if (act) {
            f32x16 p0, p1;
            qkt<DQK>(p0, p1, lds + K_OFF + b * SHM_K, r32, hi, qr);
            const int dq = qlo + r32 - kb - 4 * hi;
            if (ALIBI) { const float dqf = (float)dq, nb = -u.bias;
#pragma unroll
                for (int r = 0; r < 16; ++r) { const float c = (float)((r & 3) + 8 * (r >> 2));
                    p0[r] = fmaf(nb, dqf - c, p0[r]); p1[r] = fmaf(nb, dqf - c - 32.f, p1[r]); } }
            if (kb + 63 > qlo || kb <= qlo + 31 - W) { const float NEG = -__builtin_inff();
#pragma unroll
                for (int r = 0; r < 16; ++r) { const int c = (r & 3) + 8 * (r >> 2);
                    if ((unsigned)(dq - c) >= (unsigned)W) p0[r] = NEG;
                    if ((unsigned)(dq - c - 32) >= (unsigned)W) p1[r] = NEG; } }
            float pmax = p0[0];
#pragma unroll
            for (int r = 1; r < 16; ++r) pmax = fmaxf(pmax, p0[r]);
#pragma unroll
            for (int r = 0; r < 16; ++r) pmax = fmaxf(pmax, p1[r]);
            { auto rr = __builtin_amdgcn_permlane32_swap(__float_as_uint(pmax), __float_as_uint(pmax), false, false);
              pmax = fmaxf(__uint_as_float(rr[0]), __uint_as_float(rr[1])); }
            float mn, alpha;
            if (__builtin_expect(__all((pmax - m_reg) * u.scale <= THR), 1)) { mn = m_reg; alpha = 1.f; }
            else { mn = fmaxf(m_reg, pmax); alpha = __builtin_amdgcn_exp2f((m_reg - mn) * C2); m_reg = mn; }
            const float mnL = -mn * C2;
#pragma unroll
            for (int r = 0; r < 16; ++r) { p0[r] = __builtin_amdgcn_exp2f(fmaf(p0[r], C2, mnL)); p1[r] = __builtin_amdgcn_exp2f(fmaf(p1[r], C2, mnL)); }
            if (t + 1 < NT) FA_ISSUE(b ^ 1);
            float ps = 0.f;
#pragma unroll
            for (int r = 0; r < 16; ++r) ps += p0[r];
#pragma unroll
            for (int r = 0; r < 16; ++r) ps += p1[r];
            { auto rr = __builtin_amdgcn_permlane32_swap(__float_as_uint(ps), __float_as_uint(ps), false, false);
              ps = __uint_as_float(rr[0]) + __uint_as_float(rr[1]); }
            l_reg = l_reg * alpha + ps;
            bf16x8 pa0, pa1, pa2, pa3;
#define PK4(P, B_, OUT) do { pg8::u32x4 w = {cvtpk(P[B_+0], P[B_+1]), cvtpk(P[B_+2], P[B_+3]), cvtpk(P[B_+4], P[B_+5]), cvtpk(P[B_+6], P[B_+7])}; OUT = __builtin_bit_cast(bf16x8, w); } while (0)
            PK4(p0, 0, pa0); PK4(p0, 8, pa1); PK4(p1, 0, pa2); PK4(p1, 8, pa3);
#undef PK4
            if (__any(alpha < 1.f)) { if (hi == 0) al_l[r32] = alpha; asm volatile("s_waitcnt lgkmcnt(0)" ::: "memory");
#pragma unroll
                for (int r = 0; r < 16; ++r) { const float a = al_l[crow(r, hi)];
#pragma unroll
                    for (int d_ = 0; d_ < 4; ++d_) o[d_][r] *= a; }
                asm volatile("s_waitcnt lgkmcnt(0)" ::: "memory"); }
            pv_tile(o, vbase + b * SHM_V, pa0, pa1, pa2, pa3);
        } else if (t + 1 < NT) FA_ISSUE(b ^ 1);
    }
#undef FA_ISSUE
    if (hi == 0) li_l[r32] = l_reg; asm volatile("s_waitcnt lgkmcnt(0)" ::: "memory");
    bf16* Ow = u.O + (size_t)qlo * u.os;
#pragma unroll
    for (int r = 0; r < 16; ++r) { const int orow = crow(r, hi); const float rl = __builtin_amdgcn_rcpf(li_l[orow]);
#pragma unroll
        for (int d0 = 0; d0 < 4; ++d0) { const float v = o[d0][r] * rl;
            const float vn = __int_as_float(__builtin_amdgcn_update_dpp(0, __float_as_int(v), 0xB1, 0xF, 0xF, false));
            if ((r32 & 1) == 0) *(unsigned*)(Ow + (size_t)orow * u.os + d0 * 32 + r32) = cvtpk(v, vn); } }
    if (u.lse != nullptr && hi == 0) u.lse[(size_t)(qlo + r32) * u.ls] = m_reg * u.scale + __logf(l_reg);
    asm volatile("s_waitcnt lgkmcnt(0)" ::: "memory"); __builtin_amdgcn_s_barrier(); asm volatile("" ::: "memory");
}
}


constexpr int SEQ = 8192, DM = 2048, FF = 5632, NHEAD = 16, HD = 128;
constexpr int NQKV = 3 * DM, NUP = 2 * FF;
constexpr int KVR = 512, NKV1 = 768  , NUKV = 4096, QLR = 512, NQ = NHEAD * 192;
constexpr float EPS = 1e-6f;

constexpr size_t MiB = 1u << 20;
constexpr size_t WS_CTL = 0, CTL_ZERO_BYTES = 64 * 1024;
constexpr size_t WS_ROPE = 1 * MiB;
constexpr size_t WS_W = 4 * MiB;
constexpr size_t WGU_B = (size_t)NUP * DM * 2, WD_B = (size_t)DM * FF * 2, WFFN_B = WGU_B + WD_B;
constexpr size_t WS_WA = WS_W + 8 * WFFN_B, WA_B = 32 * MiB;
constexpr size_t WS_WKV = WS_WA + 2 * WA_B;
constexpr size_t WS_WB = WS_WKV + 8 * MiB, WB_B = 16 * MiB;
constexpr size_t WS_HB = WS_WB + 2 * WB_B;
constexpr size_t WS_ACT = WS_HB + 32 * MiB;
constexpr size_t WS_QKV = WS_ACT + 88 * MiB;
constexpr size_t WS_AO = WS_QKV + 96 * MiB;
constexpr size_t WS_KV = WS_AO + 32 * MiB;
constexpr size_t WS_KR = WS_KV + 64 * MiB;
constexpr size_t WS_CB = WS_KR + 1 * MiB;
constexpr size_t WS_OG = WS_CB + 8 * MiB;
constexpr size_t WS_LSE = WS_OG + 96 * MiB;
constexpr size_t WS_SSQ = WS_LSE + 2 * MiB;
constexpr size_t WS_XL = WS_SSQ + 1 * MiB;
constexpr size_t WS_END = WS_XL + 32 * MiB;
static_assert(WGU_B == 44 * MiB && WD_B == 22 * MiB, "weight sizes");
constexpr int CW_TMO = 0, CW_BAR = 4096;
constexpr int CW_PANEL = 8448;

constexpr int RING_OFF = 0, RING_BYTES = 131072;
constexpr int LDSCTL_OFF = RING_BYTES, MISC_OFF = LDSCTL_OFF + 320;
constexpr int TAB_OFF = RING_BYTES + 1024;
constexpr int LDS_BYTES = 147456;
constexpr int NWAVES = 8;
#ifndef TAIL_PCT
#define TAIL_PCT 100
#endif
constexpr int TAIL_C0 = ((SEQ / 256) * (NUP / 256)) % 256;

typedef unsigned short bf16;
typedef unsigned v4u __attribute__((ext_vector_type(4)));
typedef unsigned v2u __attribute__((ext_vector_type(2)));
typedef float f32x4 __attribute__((ext_vector_type(4)));
typedef float f32x2 __attribute__((ext_vector_type(2)));
#define LDS_WAIT() asm volatile("s_waitcnt lgkmcnt(0)" ::: "memory")
#define VM_WAIT() asm volatile("s_waitcnt vmcnt(0)" ::: "memory")
__device__ __forceinline__ unsigned f2bf(float f) { unsigned u = __builtin_bit_cast(unsigned, f); return (u + 0x7fffu + ((u >> 16) & 1u)) >> 16; }
__device__ __forceinline__ unsigned pk2(float lo, float hi) { return f2bf(lo) | (f2bf(hi) << 16); }
__device__ __forceinline__ float bflo(unsigned u) { return __builtin_bit_cast(float, u << 16); }
__device__ __forceinline__ float bfhi(unsigned u) { return __builtin_bit_cast(float, u & 0xffff0000u); }
__device__ __forceinline__ float wave_sum(float v) {
#pragma unroll
    for (int o = 1; o < 64; o <<= 1) v += __shfl_xor(v, o);
    return v;
}

struct Frame { LAS unsigned char* lds; unsigned* ctl; int tid, lane, wave, G, gw, NGW; };

__device__ __forceinline__ void tr_item(const float* W, int ldw, bf16* WT, int K, int drow0, int k0, int n0, LAS float* scr, int lane, const float* gain) {
    float tv[32];
    { const float* wp = W + (size_t)(k0 + (lane >> 5)) * ldw + n0 + (lane & 31);
#pragma unroll
      for (int i = 0; i < 32; ++i) tv[i] = __builtin_nontemporal_load(wp + (size_t)(2 * i) * ldw); }
#pragma unroll
    for (int i = 0; i < 32; ++i) scr[(2 * i + (lane >> 5)) * 33 + (lane & 31)] = tv[i];
    LDS_WAIT(); asm volatile("" ::: "memory");
    const int c = lane & 7;
    f32x4 g0 = {1.f, 1.f, 1.f, 1.f}, g1 = {1.f, 1.f, 1.f, 1.f};
    if (gain) { g0 = *(const f32x4*)(gain + k0 + 8 * c); g1 = *(const f32x4*)(gain + k0 + 8 * c + 4); }
#pragma unroll
    for (int j = 0; j < 4; ++j) { const int n = (lane >> 3) + 8 * j; const LAS float* s = scr + (8 * c) * 33 + n;
        v4u o; o.x = pk2(s[0 * 33] * g0.x, s[1 * 33] * g0.y); o.y = pk2(s[2 * 33] * g0.z, s[3 * 33] * g0.w); o.z = pk2(s[4 * 33] * g1.x, s[5 * 33] * g1.y); o.w = pk2(s[6 * 33] * g1.z, s[7 * 33] * g1.w);
        __builtin_nontemporal_store(o, (v4u*)(WT + (size_t)(drow0 + n) * K + k0 + 8 * c)); }
    LDS_WAIT(); asm volatile("" ::: "memory");
}
__device__ __forceinline__ void tr_mat(const float* W, int K, int N, bf16* WT, int rowoff, int mode, int r, LAS float* scr, int lane, const float* gain) {
    const int nbk = N / 32, kb = r / nbk, nb = r % nbk, n0 = nb * 32;
    const int drow0 = rowoff + (mode ? ((n0 >> 7) * 256 + (n0 & 127)) : n0);
    tr_item(W, N, WT, K, drow0, kb * 64, n0, scr, lane, gain);
}

struct Args { const float* in[23]; float* out; unsigned char* ws; int ph_lo, ph_hi; };

constexpr int I_FFN1 = (DM / 64) * (FF / 32);
constexpr int I_FFN = 3 * I_FFN1;
constexpr int I_TAIL = (I_FFN * TAIL_PCT / 100) / 1024 * 1024;
__device__ __forceinline__ void conv_ffn(const Frame& F, const Args& a, int s, int gw, int ngw, int i0, int i1) {
    LAS float* scr = (LAS float*)(F.lds + RING_OFF + F.wave * 16384);
    const int layer = s >> 1, which = s & 1;
    bf16* wgu = (bf16*)(a.ws + WS_W + (size_t)s * WFFN_B); bf16* wd = (bf16*)(a.ws + WS_W + (size_t)s * WFFN_B + WGU_B);
    const float* gain = a.in[which ? 6 : 1] + (size_t)layer * DM;
    for (int it = i0 + gw; it < i1; it += ngw) {
        int r = it;
        if (r < I_FFN1) { tr_mat(a.in[which ? 7 : 2] + (size_t)layer * DM * FF, DM, FF, wgu, 0, 1, r, scr, F.lane, gain); continue; } r -= I_FFN1;
        if (r < I_FFN1) { tr_mat(a.in[which ? 8 : 3] + (size_t)layer * DM * FF, DM, FF, wgu, 128, 1, r, scr, F.lane, gain); continue; } r -= I_FFN1;
        tr_mat(a.in[which ? 9 : 4] + (size_t)layer * FF * DM, FF, DM, wd, 0, 0, r, scr, F.lane, nullptr);
    }
}
__device__ __forceinline__ void p0_prologue(const Frame& F, const Args& a) {
    LAS float* scr = (LAS float*)(F.lds + RING_OFF + F.wave * 16384);
    unsigned char* ws = a.ws;
    constexpr int I_QKV = (DM / 64) * (NQKV / 32), I_O = (DM / 64) * (DM / 32), I_A = I_QKV + I_O;
    constexpr int I_DKV = (DM / 64) * (KVR / 32), I_KR = (DM / 64) * (64 / 32), I_UK = (KVR / 64) * (DM / 32), I_KV = I_DKV + I_KR + 2 * I_UK;
    constexpr int I_DQ = (DM / 64) * (QLR / 32), I_UQ = (QLR / 64) * (NQ / 32), I_B = I_DQ + I_UQ + I_O;
    constexpr int NITEMS = 2 * I_A + I_KV + 2 * I_B;
    conv_ffn(F, a, 0, F.gw, F.NGW, 0, I_FFN);
    for (int s = 1; s < 8; ++s) conv_ffn(F, a, s, F.gw, F.NGW, I_TAIL, I_FFN);
    for (int it = F.gw; it < NITEMS; it += F.NGW) {
        int r = it;
        if (r < 2 * I_A) { const int l = r / I_A; r -= l * I_A;
            bf16* wqkv = (bf16*)(ws + WS_WA + (size_t)l * WA_B); bf16* wo = (bf16*)(ws + WS_WA + (size_t)l * WA_B + 24 * MiB);
            if (r < I_QKV) { tr_mat(a.in[10] + (size_t)l * DM * NQKV, DM, NQKV, wqkv, 0, 0, r, scr, F.lane, a.in[5] + (size_t)l * DM); continue; } r -= I_QKV;
            tr_mat(a.in[11] + (size_t)l * DM * DM, DM, DM, wo, 0, 0, r, scr, F.lane, nullptr); continue; }
        r -= 2 * I_A;
        if (r < I_KV) { bf16* wdkv = (bf16*)(ws + WS_WKV); bf16* wukv = (bf16*)(ws + WS_WKV + 3 * MiB);
            if (r < I_DKV) { tr_mat(a.in[13], DM, KVR, wdkv, 0, 0, r, scr, F.lane, a.in[12]); continue; } r -= I_DKV;
            if (r < I_KR) { tr_mat(a.in[15], DM, 64, wdkv, KVR, 0, r, scr, F.lane, a.in[12]); continue; } r -= I_KR;
            if (r < I_UK) { tr_mat(a.in[16], KVR, DM, wukv, 0, 0, r, scr, F.lane, nullptr); continue; } r -= I_UK;
            tr_mat(a.in[17], KVR, DM, wukv, DM, 0, r, scr, F.lane, nullptr); continue; }
        r -= I_KV;
        { const int l = r / I_B; r -= l * I_B;
            bf16* wdq = (bf16*)(ws + WS_WB + (size_t)l * WB_B); bf16* wuq = (bf16*)(ws + WS_WB + (size_t)l * WB_B + 2 * MiB); bf16* wo = (bf16*)(ws + WS_WB + (size_t)l * WB_B + 8 * MiB);
            if (r < I_DQ) { tr_mat(a.in[18] + (size_t)l * DM * QLR, DM, QLR, wdq, 0, 0, r, scr, F.lane, a.in[5] + (size_t)(2 + l) * DM); continue; } r -= I_DQ;
            if (r < I_UQ) { tr_mat(a.in[20] + (size_t)l * QLR * NQ, QLR, NQ, wuq, 0, 0, r, scr, F.lane, nullptr); continue; } r -= I_UQ;
            tr_mat(a.in[21] + (size_t)l * DM * DM, DM, DM, wo, 0, 0, r, scr, F.lane, nullptr); }
    }
    const int gt = blockIdx.x * (NWAVES * 64) + F.tid, NGT = F.G * NWAVES * 64;
    { v4u* z = (v4u*)(ws + WS_WKV + (size_t)576 * DM * 2); const v4u zero = {0u, 0u, 0u, 0u};
      for (int i = gt; i < (NKV1 - 576) * DM * 2 / 16; i += NGT) z[i] = zero; }
    { f32x2* tab = (f32x2*)(ws + WS_ROPE);
      for (int i = gt; i < SEQ * 32; i += NGT) { const int pos = i >> 5, j = i & 31;
          const float inv = 1.0f / exp2f((float)j * (13.287712379549449f / 32.0f));
          const float ang = (float)pos * inv;
          double t = (double)ang * 0.15915494309189535; t -= floor(t); const float tf = (float)t;
          f32x2 cs; cs.x = __builtin_amdgcn_cosf(tf); cs.y = __builtin_amdgcn_sinf(tf); tab[i] = cs; } }
    { bf16* xb = (bf16*)(ws + WS_HB); bf16* xl = (bf16*)(ws + WS_XL); float* ssq = (float*)(ws + WS_SSQ); const float* x = a.in[0];
      for (int m = F.gw; m < SEQ; m += F.NGW) {
          const f32x4* xr = (const f32x4*)(x + (size_t)m * DM) + F.lane; v2u* o = (v2u*)(xb + (size_t)m * DM) + F.lane; v2u* ol = (v2u*)(xl + (size_t)m * DM) + F.lane; float s = 0.f;
          f32x4 v[8];
#pragma unroll
          for (int j = 0; j < 8; ++j) v[j] = __builtin_nontemporal_load(xr + 64 * j);
#pragma unroll
          for (int j = 0; j < 8; ++j) { s += (v[j].x * v[j].x + v[j].y * v[j].y) + (v[j].z * v[j].z + v[j].w * v[j].w); v2u w; w.x = pk2(v[j].x, v[j].y); w.y = pk2(v[j].z, v[j].w); o[64 * j] = w;
              if (RESID_LO) { v2u wl; wl.x = pk2(v[j].x - bflo(w.x), v[j].y - bfhi(w.x)); wl.y = pk2(v[j].z - bflo(w.y), v[j].w - bfhi(w.y)); ol[64 * j] = wl; } }
          s = wave_sum(s);
          if (F.lane < 8) ssq[(size_t)m * 8 + F.lane] = (F.lane == 0) ? s : 0.f; } }
}
__device__ __forceinline__ void fill_rstd_tab(const Frame& F, const float* ssq, int fm256) {
    LAS float* tab = (LAS float*)(F.lds + TAB_OFF);
    for (int i = F.tid; i < 256; i += NWAVES * 64) { const f32x4 a = *(const f32x4*)(ssq + (size_t)(fm256 + i) * 8), b = *(const f32x4*)(ssq + (size_t)(fm256 + i) * 8 + 4);
        const float s = ((a.x + a.y) + (a.z + a.w)) + ((b.x + b.y) + (b.z + b.w)); tab[i] = 1.0f / sqrtf(s * (1.0f / DM) + EPS); }
    __syncthreads();
}

__device__ __forceinline__ void norm_rows_bf16(const Frame& F, const float* x, const float* gain, bf16* out) {
    for (int m = F.gw; m < SEQ; m += F.NGW) {
        const f32x4* xr = (const f32x4*)(x + (size_t)m * DM) + F.lane; const f32x4* g4 = (const f32x4*)gain + F.lane;
        f32x4 v[8]; float s = 0.f;
#pragma unroll
        for (int j = 0; j < 8; ++j) { v[j] = xr[64 * j]; s += (v[j].x * v[j].x + v[j].y * v[j].y) + (v[j].z * v[j].z + v[j].w * v[j].w); }
        const float rstd = 1.0f / sqrtf(wave_sum(s) * (1.0f / DM) + EPS);
        v2u* o = (v2u*)(out + (size_t)m * DM) + F.lane;
#pragma unroll
        for (int j = 0; j < 8; ++j) { const f32x4 g = g4[64 * j]; v2u w; w.x = pk2(v[j].x * rstd * g.x, v[j].y * rstd * g.y); w.y = pk2(v[j].z * rstd * g.z, v[j].w * rstd * g.w); o[64 * j] = w; }
    }
}
__device__ __forceinline__ void norm_rows_f32(const Frame& F, const float* x, const float* gain, float* out) {
    for (int m = F.gw; m < SEQ; m += F.NGW) {
        const f32x4* xr = (const f32x4*)(x + (size_t)m * DM) + F.lane; const f32x4* g4 = (const f32x4*)gain + F.lane;
        f32x4 v[8]; float s = 0.f;
#pragma unroll
        for (int j = 0; j < 8; ++j) { v[j] = xr[64 * j]; s += (v[j].x * v[j].x + v[j].y * v[j].y) + (v[j].z * v[j].z + v[j].w * v[j].w); }
        const float rstd = 1.0f / sqrtf(wave_sum(s) * (1.0f / DM) + EPS);
        f32x4* o = (f32x4*)(out + (size_t)m * DM) + F.lane;
#pragma unroll
        for (int j = 0; j < 8; ++j) { const f32x4 g = g4[64 * j]; __builtin_nontemporal_store(v[j] * rstd * g, o + 64 * j); }
    }
}
template <int NS, int LD, bool KR>
__device__ __forceinline__ void latent_post(const Frame& F, const bf16* raw, const float* gain, bf16* cb, bf16* kr, const f32x2* ropetab, const float* ssq) {
    const int bxl = F.gw / NWAVES, pan = 4 * (bxl & 7) + ((bxl >> 3) & 3), lw = (bxl >> 5) * NWAVES + F.wave;
    for (int m = 256 * pan + lw; m < 256 * (pan + 1); m += 64) {
        f32x4 v0 = {0.f, 0.f, 0.f, 0.f}, v1 = {0.f, 0.f, 0.f, 0.f}; float t1 = 0.f, t2 = 0.f;
        const f32x4 qa = *(const f32x4*)(ssq + (size_t)m * 8), qb = *(const f32x4*)(ssq + (size_t)m * 8 + 4);
        const float rsx = 1.0f / sqrtf((((qa.x + qa.y) + (qa.z + qa.w)) + ((qb.x + qb.y) + (qb.z + qb.w))) * (1.0f / DM) + EPS);
#pragma unroll
        for (int p = 0; p < NS; ++p) { const bf16* rr = raw + (size_t)p * SEQ * LD + (size_t)m * LD;
            const v4u w = __builtin_nontemporal_load((const v4u*)(rr + 8 * F.lane));
            v0 += (f32x4){bflo(w.x), bfhi(w.x), bflo(w.y), bfhi(w.y)}; v1 += (f32x4){bflo(w.z), bfhi(w.z), bflo(w.w), bfhi(w.w)};
            if (KR) { t1 += bflo((unsigned)rr[512 + (F.lane & 31)]); t2 += bflo((unsigned)rr[544 + (F.lane & 31)]); } }
        v0 *= rsx; v1 *= rsx; t1 *= rsx; t2 *= rsx;
        const float s = (v0.x * v0.x + v0.y * v0.y) + (v0.z * v0.z + v0.w * v0.w) + (v1.x * v1.x + v1.y * v1.y) + (v1.z * v1.z + v1.w * v1.w);
        const float rstd = 1.0f / sqrtf(wave_sum(s) * (1.0f / 512.0f) + EPS);
        const f32x4 g0 = *(const f32x4*)(gain + 8 * F.lane), g1 = *(const f32x4*)(gain + 8 * F.lane + 4);
        v4u w; w.x = pk2(v0.x * rstd * g0.x, v0.y * rstd * g0.y); w.y = pk2(v0.z * rstd * g0.z, v0.w * rstd * g0.w);
        w.z = pk2(v1.x * rstd * g1.x, v1.y * rstd * g1.y); w.w = pk2(v1.z * rstd * g1.z, v1.w * rstd * g1.w);
        *(v4u*)(cb + (size_t)m * 512 + 8 * F.lane) = w;
        if (KR) { const f32x2 cs = ropetab[m * 32 + (F.lane & 31)];
            const float r = (F.lane < 32) ? (t1 * cs.x - t2 * cs.y) : (t1 * cs.y + t2 * cs.x);
            kr[(size_t)m * 64 + F.lane] = (bf16)f2bf(r); }
    }
}
__device__ __forceinline__ void attn_dilated_phase(LAS unsigned char* lds, const bf16* qkv, bf16* og, float* lse, int G, int bx) {
    for (int uix = bx; uix < 3 * 512; uix += G) {
        const int g = uix >> 9, rem = uix & 511, h = rem & 15, rb = rem >> 4, d = 1 << (2 * g), r = rb & (d - 1), b = rb >> (2 * g);
        const float slope = exp2f(-0.5f * (float)(h + 1)), scale = 0.08838834764831845f;
        fa::UnitArgs u;
        u.Q = qkv + (size_t)r * NQKV + h * HD; u.qs = (size_t)d * NQKV; u.K = u.Q + DM; u.ks = u.qs; u.Kr = nullptr; u.krs = 0; u.V = u.Q + 2 * DM; u.vs = u.qs;
        u.O = og + (size_t)g * SEQ * DM + (size_t)r * DM + h * HD; u.os = (size_t)d * DM; u.lse = lse + (size_t)g * SEQ * NHEAD + r * NHEAD + h; u.ls = (size_t)d * NHEAD;
        u.q0 = b * 256; u.W = 129; u.scale = scale; u.bias = slope * (float)d / scale; u.rope = nullptr; u.rev = 0;
        fa::attn_unit<128, true>(lds, u);
    }
}
__device__ __forceinline__ void attn_combine_phase(const Frame& F, const bf16* og, const float* lse, bf16* ao) {
    const int bxl = F.gw / NWAVES, pan = 4 * (bxl & 7) + ((bxl >> 3) & 3), lw = (bxl >> 5) * NWAVES + F.wave;
    for (int p = 256 * pan + lw; p < 256 * (pan + 1); p += 64) {
        v4u va[4], vb[4], vc[4]; float l0[4], l1[4], l2[4];
#pragma unroll
        for (int j = 0; j < 4; ++j) { const int c0 = (j * 64 + F.lane) * 8, h = c0 >> 7;
            l0[j] = lse[(size_t)p * NHEAD + h]; l1[j] = lse[(size_t)(SEQ + p) * NHEAD + h]; l2[j] = lse[(size_t)(2 * SEQ + p) * NHEAD + h];
            va[j] = __builtin_nontemporal_load((const v4u*)(og + (size_t)p * DM + c0)); vb[j] = __builtin_nontemporal_load((const v4u*)(og + (size_t)(SEQ + p) * DM + c0)); vc[j] = __builtin_nontemporal_load((const v4u*)(og + (size_t)(2 * SEQ + p) * DM + c0)); }
#pragma unroll
        for (int j = 0; j < 4; ++j) { const int c0 = (j * 64 + F.lane) * 8;
            const float mx = fmaxf(l0[j], fmaxf(l1[j], l2[j])); float w0 = __expf(l0[j] - mx), w1 = __expf(l1[j] - mx), w2 = __expf(l2[j] - mx);
            const float inv = 1.0f / (w0 + w1 + w2); w0 *= inv; w1 *= inv; w2 *= inv;
            v4u o;
#pragma unroll
            for (int e = 0; e < 4; ++e) o[e] = pk2(w0 * bflo(va[j][e]) + w1 * bflo(vb[j][e]) + w2 * bflo(vc[j][e]), w0 * bfhi(va[j][e]) + w1 * bfhi(vb[j][e]) + w2 * bfhi(vc[j][e]));
            *(v4u*)(ao + (size_t)p * DM + c0) = o; }
    }
}
__device__ __forceinline__ void attn_mla_phase(LAS unsigned char* lds, const bf16* q, const bf16* kv, const bf16* kr, bf16* ao, const float* rope, int G, int bx) {
    for (int it = bx; it < 256; it += G) {
        const int xcd = it & 7, idx = it >> 3, h = xcd * 2 + (idx >> 4), pr = idx & 15;
        for (int pass = 0; pass < 2; ++pass) {
            fa::UnitArgs u;
            u.Q = q + h * 192; u.qs = NQ; u.K = kv + h * HD; u.ks = NUKV; u.Kr = kr; u.krs = 64; u.V = kv + DM + h * HD; u.vs = NUKV;
            u.O = ao + h * HD; u.os = DM; u.lse = nullptr; u.ls = 0; u.q0 = (pass ? pr : 31 - pr) * 256;     u.W = 1 << 30; u.scale = 0.07216878364870322f; u.bias = 0.f; u.rope = rope; u.rev = pass;
            fa::attn_unit<192, false>(lds, u);
        }
    }
}

typedef const volatile Args __attribute__((address_space(4))) KArgs;
__global__ void __launch_bounds__(NWAVES * 64, 2) mk_fwd(Args args) {
    KArgs* const ka = (KArgs*)__builtin_amdgcn_kernarg_segment_ptr();
#define IN(k) ((const float*)ka->in[k])
    extern __shared__ __attribute__((aligned(16))) unsigned char lds_raw[];
    LAS unsigned char* const LDSB = (LAS unsigned char*)lds_raw;
    volatile LAS unsigned* MISC = (volatile LAS unsigned*)(LDSB + MISC_OFF);
    unsigned char* ws = args.ws;
    unsigned* const CTL = (unsigned*)(ws + WS_CTL);
    for (int u = threadIdx.x; u < (LDS_BYTES - LDSCTL_OFF) / 4; u += NWAVES * 64) ((LAS unsigned*)(LDSB + LDSCTL_OFF))[u] = 0u;
    __syncthreads();
    XcdBarrier bar; bar.bar = CTL + CW_BAR; bar.x = 0; bar.st = nullptr;
    if (!MK_PER_PHASE) bar = xcd_barrier_post(CTL + CW_BAR, MISC + 8);
    const int lo = args.ph_lo, hi = args.ph_hi;
    int ph = 0;
#if SEAM_PROBE
#define SEAM_T0(kind) bar.probe = (SEAM_MASK >> (kind)) & 1u;
#define SEAM_T1(kind)
#else
#define SEAM_T0(kind)
#define SEAM_T1(kind)
#endif
#define PH_BEGIN(kind) if (ph >= lo && ph < hi) { const unsigned long long pt0_ = ((PROBE_MASK >> (kind)) & 1u) ? __builtin_amdgcn_s_memrealtime() : 0ull; Frame F; F.lds = LDSB; F.ctl = CTL; F.tid = pg8::opaque_tid(); F.lane = F.tid & 63; F.wave = __builtin_amdgcn_readfirstlane(F.tid >> 6); F.G = gridDim.x; \
    const int bx = (ph == 0) ? (int)blockIdx.x : __builtin_amdgcn_readfirstlane((int)MISC[12]);     \
    F.gw = bx * NWAVES + F.wave; F.NGW = F.G * NWAVES;
#define PH_END(kind, LOCAL) if ((PROBE_MASK >> (kind)) & 1u) { const unsigned long long pt1_ = __builtin_amdgcn_s_memrealtime(); while (__builtin_amdgcn_s_memrealtime() - pt1_ < pt1_ - pt0_) __builtin_amdgcn_s_sleep(8); } \
    } ++ph; if (!MK_PER_PHASE && ph > lo && ph < hi) { SEAM_T0(kind) if ((LOCAL) && __builtin_amdgcn_readfirstlane((int)MISC[11]) != 0) xcd_local_barrier(bar); else xcd_barrier(bar); SEAM_T1(kind) if (PROBE_MASK >> 31) xcd_barrier(bar); }

    float* X = args.out;
    bf16* XL = (bf16*)(ws + WS_XL);
    bf16* XB = (bf16*)(ws + WS_HB); float* SSQ = (float*)(ws + WS_SSQ); bf16* ACT = (bf16*)(ws + WS_ACT); bf16* QKV = (bf16*)(ws + WS_QKV); bf16* AO = (bf16*)(ws + WS_AO);
    bf16* KV = (bf16*)(ws + WS_KV); bf16* KR = (bf16*)(ws + WS_KR); bf16* CB = (bf16*)(ws + WS_CB);
    bf16* RAW = (bf16*)(ws + WS_OG + 32 * MiB); bf16* RAWKV = (bf16*)(ws + WS_OG); bf16* OG = (bf16*)(ws + WS_OG); float* LSE = (float*)(ws + WS_LSE);
    const f32x2* ROPETAB = (const f32x2*)(ws + WS_ROPE);

    PH_BEGIN(0) p0_prologue(F, args); PH_END(0, 0)

    for (int s = 0; s < 8; ++s) {
        const int layer = s >> 1, which = s & 1;
        if (s == 4) {
            PH_BEGIN(13) { pg8::Gemm g{XB, (const bf16*)(ws + WS_WKV), DM, DM, DM / 2}; pg8::StaticOrder S; S.init(SEQ, NKV1, 2, F.G, bx);
                       pg8::EpiBf16 E{RAWKV, NKV1, nullptr, 0, (size_t)SEQ * NKV1};
                       pg8::gemm_phase<pg8::EpiBf16, pg8::StaticOrder, true, true>(F.lds + RING_OFF, g, S, E); } PH_END(13, 1)
            PH_BEGIN(14) latent_post<2, NKV1, true>(F, RAWKV, IN(14), CB, KR, ROPETAB, SSQ); PH_END(14, 1)
            PH_BEGIN(15) { pg8::Gemm g{CB, (const bf16*)(ws + WS_WKV + 3 * MiB), KVR, KVR, KVR}; pg8::StaticOrder S; S.init(SEQ, NUKV, 1, F.G, bx);
                       pg8::EpiBf16 E{KV, NUKV, nullptr, 0};
                       pg8::gemm_phase<pg8::EpiBf16, pg8::StaticOrder, true, true>(F.lds + RING_OFF, g, S, E); } PH_END(15, 1)
        }
        PH_BEGIN(1) { pg8::Gemm g{XB, (const bf16*)(ws + WS_W + (size_t)s * WFFN_B), DM, DM, DM}; pg8::StaticOrder S; S.init(SEQ, NUP, 1, F.G, bx);
                   pg8::Unit u0; const int fm256 = S.next(0, u0) ? u0.pm * 256 : 0; fill_rstd_tab(F, SSQ, fm256);
                   pg8::EpiSwiGLU E{ACT, FF, (const LAS float*)(F.lds + TAB_OFF), fm256};
                   pg8::gemm_phase<pg8::EpiSwiGLU, pg8::StaticOrder, true, true>(F.lds + RING_OFF, g, S, E);
                   if (s < 7 && bx >= TAIL_C0) conv_ffn(F, args, s + 1, (bx - TAIL_C0) * NWAVES + F.wave, (256 - TAIL_C0) * NWAVES, 0, I_TAIL); } PH_END(1, 1)
        PH_BEGIN(2) { pg8::Gemm g{ACT, (const bf16*)(ws + WS_W + (size_t)s * WFFN_B + WGU_B), FF, FF, FF}; pg8::StaticOrder S; S.init(SEQ, DM, 1, F.G, bx);
                   if (s < 7) { pg8::EpiResidStats E{XB, XL, SSQ, DM, 0.5f};
                       pg8::gemm_phase<pg8::EpiResidStats, pg8::StaticOrder, false, true>(F.lds + RING_OFF, g, S, E); }
                   else {
                       pg8::EpiResidFinal E{XB, XL, X, SSQ, IN(22), F.ctl + CW_PANEL, F.ctl + CW_BAR + XB_TMO, DM, 0.5f, EPS};
                       pg8::gemm_phase<pg8::EpiResidFinal, pg8::StaticOrder, false, true>(F.lds + RING_OFF, g, S, E); } } PH_END(2, (s & 1) == 0)
        if (which == 0) {
            if (layer < 2) {
                PH_BEGIN(3) { pg8::Gemm g{XB, (const bf16*)(ws + WS_WA + (size_t)layer * WA_B), DM, DM, DM}; pg8::StaticOrder S; S.init(SEQ, NQKV, 1, F.G, bx);
                           pg8::Unit u0; const int fm256 = S.next(0, u0) ? u0.pm * 256 : 0; fill_rstd_tab(F, SSQ, fm256);
                           pg8::EpiBf16 E{QKV, NQKV, (const LAS float*)(F.lds + TAB_OFF), fm256};
                           pg8::gemm_phase<pg8::EpiBf16, pg8::StaticOrder, true, true>(F.lds + RING_OFF, g, S, E); } PH_END(3, 0)
                PH_BEGIN(4) attn_dilated_phase(F.lds + RING_OFF, QKV, OG, LSE, F.G, bx); PH_END(4, 0)
                PH_BEGIN(5) attn_combine_phase(F, OG, LSE, AO); PH_END(5, 1)
                PH_BEGIN(6) { pg8::Gemm g{AO, (const bf16*)(ws + WS_WA + (size_t)layer * WA_B + 24 * MiB), DM, DM, DM}; pg8::StaticOrder S; S.init(SEQ, DM, 1, F.G, bx);
                           pg8::EpiResidStats E{XB, XL, SSQ, DM, 1.0f};
                           pg8::gemm_phase<pg8::EpiResidStats, pg8::StaticOrder, false, true>(F.lds + RING_OFF, g, S, E); } PH_END(6, 1)
            } else {
                const int jb = layer - 2;
                PH_BEGIN(7) { pg8::Gemm g{XB, (const bf16*)(ws + WS_WB + (size_t)jb * WB_B), DM, DM, DM / 4}; pg8::StaticOrder S; S.init(SEQ, QLR, 4, F.G, bx);
                           pg8::EpiBf16 E{RAW, QLR, nullptr, 0, (size_t)SEQ * QLR};
                           pg8::gemm_phase<pg8::EpiBf16, pg8::StaticOrder, true, true>(F.lds + RING_OFF, g, S, E); } PH_END(7, 1)
                PH_BEGIN(8) latent_post<4, QLR, false>(F, RAW, IN(19) + (size_t)jb * QLR, CB, nullptr, ROPETAB, SSQ); PH_END(8, 1)
                PH_BEGIN(9) { pg8::Gemm g{CB, (const bf16*)(ws + WS_WB + (size_t)jb * WB_B + 2 * MiB), QLR, QLR, QLR}; pg8::StaticOrder S; S.init(SEQ, NQ, 1, F.G, bx);
                           pg8::EpiBf16 E{QKV, NQ, nullptr, 0};
                           pg8::gemm_phase<pg8::EpiBf16, pg8::StaticOrder, true, true>(F.lds + RING_OFF, g, S, E); } PH_END(9, 0)
                PH_BEGIN(11) attn_mla_phase(F.lds + RING_OFF, QKV, KV, KR, AO, (const float*)ROPETAB, F.G, bx); PH_END(11, 0)
                PH_BEGIN(12) { pg8::Gemm g{AO, (const bf16*)(ws + WS_WB + (size_t)jb * WB_B + 8 * MiB), DM, DM, DM}; pg8::StaticOrder S; S.init(SEQ, DM, 1, F.G, bx);
                           pg8::EpiResidStats E{XB, XL, SSQ, DM, 1.0f};
                           pg8::gemm_phase<pg8::EpiResidStats, pg8::StaticOrder, false, true>(F.lds + RING_OFF, g, S, E); } PH_END(12, 1)
            }
        }
    }
#if SEAM_PROBE
    if (bx == 0 && threadIdx.x == 0) { const unsigned ticks = xb_ld(&CTL[8192]) / 256u;
        const unsigned long long t0 = __builtin_amdgcn_s_memrealtime(); while (__builtin_amdgcn_s_memrealtime() - t0 < ticks) __builtin_amdgcn_s_sleep(8); }
#endif
#undef PH_BEGIN
#undef PH_END
}
constexpr int N_PHASES = 1 + 8 * 2 + 2 * 4 + 2 * 5 + 3;

extern "C" void kernel_launch(void* const* d_in, const int* in_sizes, int n_in, void* d_out, int out_size, void* d_ws, size_t ws_size, hipStream_t stream) {
    static int grid = 0;
    if (grid == 0) {
        if (n_in != 23 || in_sizes[0] != SEQ * DM || out_size != SEQ * DM || ws_size < WS_END) {
            fprintf(stderr, "kernel_launch: shape/workspace mismatch: n_in %d in0 %d out %d ws %zu (need %zu); nothing launched\n", n_in, n_in > 0 ? in_sizes[0] : -1, out_size, ws_size, (size_t)WS_END); grid = -1; return; }
        int dev = 0, cus = 0, per_cu = 0;
        if (hipGetDevice(&dev) != hipSuccess || hipDeviceGetAttribute(&cus, hipDeviceAttributeMultiprocessorCount, dev) != hipSuccess) { fprintf(stderr, "kernel_launch: device query failed\n"); grid = -1; return; }
        if (hipFuncSetAttribute((const void*)mk_fwd, hipFuncAttributeMaxDynamicSharedMemorySize, LDS_BYTES) != hipSuccess) { fprintf(stderr, "kernel_launch: hipFuncSetAttribute failed\n"); grid = -1; return; }
        if (hipOccupancyMaxActiveBlocksPerMultiprocessor(&per_cu, (const void*)mk_fwd, NWAVES * 64, LDS_BYTES) != hipSuccess || per_cu < 1)
            fprintf(stderr, "kernel_launch: note: occupancy query reports %d workgroups per CU\n", per_cu);
        (void)hipGetLastError();
        grid = cus;
        if (grid != 256) { fprintf(stderr, "kernel_launch: built for a 256-CU device (one 256x256 unit per workgroup in the residual GEMM phases), found %d CUs; nothing launched\n", grid); grid = -1; return; }
    }
    if (grid < 0) return;
    if (hipMemsetAsync((char*)d_ws + WS_CTL, 0, CTL_ZERO_BYTES, stream) != hipSuccess) { fprintf(stderr, "kernel_launch: memset failed\n"); return; }
    Args a{};
    for (int i = 0; i < 23; ++i) a.in[i] = (const float*)d_in[i];
    a.out = (float*)d_out; a.ws = (unsigned char*)d_ws;
#if MK_PER_PHASE
    for (int p = 0; p < N_PHASES; ++p) { a.ph_lo = p; a.ph_hi = p + 1; hipLaunchKernelGGL(mk_fwd, dim3(grid), dim3(NWAVES * 64), LDS_BYTES, stream, a); }
#else
    a.ph_lo = 0; a.ph_hi = N_PHASES;
    hipLaunchKernelGGL(mk_fwd, dim3(grid), dim3(NWAVES * 64), LDS_BYTES, stream, a);
#endif
    const hipError_t le = hipPeekAtLastError();
    if (le != hipSuccess) fprintf(stderr, "kernel_launch: launch failed: %s\n", hipGetErrorName(le));
}
```
